# Optimizing an MI355X kernel written in HIP

```python
import jax, jax.numpy as jnp
from jax import lax
import numpy as np

D_MODEL = 1024
BATCH = 8
SEQ = 4096
DEPTH = 1

GLA_HEADS = 4
GLA_DK = D_MODEL // 8
GLA_DV = D_MODEL // 4
GLA_RANK = 16
GLA_TAU = 16.0
GLA_CHUNK = 64
SWA_HEADS = 16
SWA_KV_HEADS = 2
SWA_HEAD_DIM = 64
SWA_WINDOW = 128
ROPE_DIM = SWA_HEAD_DIM // 4
ROPE_THETA = 500000.0
D_FF = -((-8 * D_MODEL) // (3 * 256)) * 256

GLA_QK = GLA_HEADS * GLA_DK
GLA_V = GLA_HEADS * GLA_DV
SWA_Q = SWA_HEADS * SWA_HEAD_DIM
SWA_KV = SWA_KV_HEADS * SWA_HEAD_DIM
SPLIT_SIZES = (GLA_QK, GLA_QK, GLA_V, GLA_V, GLA_RANK, SWA_Q, SWA_KV, SWA_KV, D_MODEL, D_MODEL)
D_IN = sum(SPLIT_SIZES)
SPLIT_POINTS = tuple(int(s) for s in np.cumsum(SPLIT_SIZES)[:-1])

DEEPNORM_ALPHA = (2.0 * DEPTH) ** 0.25
DEEPNORM_BETA = (8.0 * DEPTH) ** -0.25
LN_EPS = 1e-5
RMS_EPS = 1e-6

kernel_name = 'hybrid_gla_swa_sink_gated_deepnorm'


def layer_norm(x, g, b):
    xf = x.astype(jnp.float32)
    mu = jnp.mean(xf, axis=-1, keepdims=True)
    var = jnp.mean(jnp.square(xf - mu), axis=-1, keepdims=True)
    y = (xf - mu) * lax.rsqrt(var + LN_EPS) * g.astype(jnp.float32) + b.astype(jnp.float32)
    return y.astype(x.dtype)


def gla_chunked(q, k, v, log_a):
    B, T, H, dk = q.shape
    dv = v.shape[-1]
    C = GLA_CHUNK
    N = T // C

    def to_chunks(t):
        return t.astype(jnp.float32).reshape(B, N, C, H, t.shape[-1]).transpose(1, 0, 3, 2, 4)

    q, k, v, log_a = map(to_chunks, (q, k, v, log_a))
    b = jnp.cumsum(log_a, axis=-2)
    b_last = b[..., -1:, :]
    q_in = q * jnp.exp(b)
    k_in = k * jnp.exp(-b)
    k_out = k * jnp.exp(b_last - b)
    causal = jnp.tril(jnp.ones((C, C), dtype=bool))
    scores = jnp.where(causal, jnp.einsum('nbhtd,nbhsd->nbhts', q_in, k_in), 0.0)
    o_intra = jnp.einsum('nbhts,nbhsv->nbhtv', scores, v)

    def step(S, inp):
        q_c, k_c, v_c, decay = inp
        o = jnp.einsum('bhtd,bhdv->bhtv', q_c, S)
        S = S * decay[..., 0, :, None] + jnp.einsum('bhsd,bhsv->bhdv', k_c, v_c)
        return S, o

    S0 = jnp.zeros((B, H, dk, dv), jnp.float32)
    _, o_inter = lax.scan(step, S0, (q_in, k_out, v, jnp.exp(b_last)))
    o = o_intra + o_inter
    return o.transpose(1, 0, 3, 2, 4).reshape(B, T, H, dv)


def partial_rope(t, positions):
    half = ROPE_DIM // 2
    inv_freq = ROPE_THETA ** (-jnp.arange(0, ROPE_DIM, 2, dtype=jnp.float32) / ROPE_DIM)
    ang = positions.astype(jnp.float32)[..., None] * inv_freq
    cos = jnp.cos(ang)[:, :, None, :]
    sin = jnp.sin(ang)[:, :, None, :]
    tf = t.astype(jnp.float32)
    x1, x2, keep = tf[..., :half], tf[..., half:ROPE_DIM], tf[..., ROPE_DIM:]
    out = jnp.concatenate([x1 * cos - x2 * sin, x1 * sin + x2 * cos, keep], axis=-1)
    return out.astype(t.dtype)


def swa_sink_attention(q, k, v, sinks):
    B, T, Hq, Dh = q.shape
    Hkv = k.shape[2]
    G = Hq // Hkv
    W = SWA_WINDOW
    N = T // W
    qb = q.astype(jnp.float32).reshape(B, N, W, Hkv, G, Dh)
    kb = k.astype(jnp.float32).reshape(B, N, W, Hkv, Dh)
    vb = v.astype(jnp.float32).reshape(B, N, W, Hkv, Dh)

    def with_prev(t):
        prev = jnp.concatenate([jnp.zeros_like(t[:, :1]), t[:, :-1]], axis=1)
        return jnp.concatenate([prev, t], axis=2)

    k2, v2 = with_prev(kb), with_prev(vb)
    scores = jnp.einsum('bnqhgd,bnkhd->bhgnqk', qb, k2) * (Dh ** -0.5)
    q_pos = jnp.arange(W)[None, :, None] + W
    k_pos = jnp.arange(2 * W)[None, None, :]
    blk = jnp.arange(N)[:, None, None]
    valid = (k_pos <= q_pos) & (k_pos > q_pos - W) & ((blk > 0) | (k_pos >= W))
    scores = jnp.where(valid, scores, -jnp.inf)
    sink = sinks.astype(jnp.float32).reshape(Hkv, G)[None, :, :, None, None, None]
    m = jnp.maximum(jnp.max(scores, axis=-1, keepdims=True), sink)
    p = jnp.exp(scores - m)
    denom = jnp.sum(p, axis=-1, keepdims=True) + jnp.exp(sink - m)
    out = jnp.einsum('bhgnqk,bnkhd->bnqhgd', p / denom, v2)
    return out.reshape(B, T, Hq, Dh).astype(q.dtype)


def hybrid_mixer(h, positions, w_in, w_decay_up, b_decay, gla_norm_g,
                 w_branch_a, w_branch_b, sinks, w_out):
    B, T, _ = h.shape
    proj = h @ w_in
    q_a, k_a, v_a, r_a, d_low, q_b, k_b, v_b, g_a, g_b = jnp.split(proj, SPLIT_POINTS, axis=-1)

    log_a = jax.nn.log_sigmoid((d_low @ w_decay_up + b_decay).astype(jnp.float32)) / GLA_TAU
    q_a = q_a.reshape(B, T, GLA_HEADS, GLA_DK) * (GLA_DK ** -0.5)
    o_a = gla_chunked(q_a, k_a.reshape(B, T, GLA_HEADS, GLA_DK),
                      v_a.reshape(B, T, GLA_HEADS, GLA_DV),
                      log_a.reshape(B, T, GLA_HEADS, GLA_DK))
    o_a = o_a * lax.rsqrt(jnp.mean(jnp.square(o_a), axis=-1, keepdims=True) + RMS_EPS)
    o_a = o_a * gla_norm_g.astype(jnp.float32)
    o_a = (o_a.astype(h.dtype) * jax.nn.silu(r_a.reshape(B, T, GLA_HEADS, GLA_DV))).reshape(B, T, GLA_V)
    y_a = o_a @ w_branch_a

    q_b = partial_rope(q_b.reshape(B, T, SWA_HEADS, SWA_HEAD_DIM), positions)
    k_b = partial_rope(k_b.reshape(B, T, SWA_KV_HEADS, SWA_HEAD_DIM), positions)
    o_b = swa_sink_attention(q_b, k_b, v_b.reshape(B, T, SWA_KV_HEADS, SWA_HEAD_DIM), sinks)
    y_b = o_b.reshape(B, T, SWA_Q) @ w_branch_b

    merged = jax.nn.sigmoid(g_a) * y_a + jax.nn.sigmoid(g_b) * y_b
    return merged @ w_out


def swiglu_ffn(h, w_gate, w_up, w_down):
    return (jax.nn.silu(h @ w_gate) * (h @ w_up)) @ w_down


def setup_inputs(seed: int = 0) -> dict:
    key = jax.random.key(seed)
    ks = jax.random.split(key, 18)
    f32 = jnp.float32
    L = DEPTH

    def nrm(k, shape, fan_in, scale=1.0):
        return jax.random.normal(k, shape, f32) * (scale * fan_in ** -0.5)

    def gain(k, shape):
        return 1.0 + 0.02 * jax.random.normal(k, shape, f32)

    def bias(k, shape, s=0.02):
        return s * jax.random.normal(k, shape, f32)

    x = jax.random.normal(ks[0], (BATCH, SEQ, D_MODEL), f32)
    offset = jax.random.randint(ks[1], (BATCH, 1), 0, 1024, dtype=jnp.int32)
    positions = offset + jnp.arange(SEQ, dtype=jnp.int32)[None, :]
    return {
        'x': x,
        'positions': positions,
        'w_in': nrm(ks[2], (L, D_MODEL, D_IN), D_MODEL),
        'w_decay_up': nrm(ks[3], (L, GLA_RANK, GLA_QK), GLA_RANK),
        'b_decay': bias(ks[4], (L, GLA_QK), 0.1),
        'gla_norm_g': gain(ks[5], (L, GLA_DV)),
        'w_branch_a': nrm(ks[6], (L, GLA_V, D_MODEL), GLA_V),
        'w_branch_b': nrm(ks[7], (L, SWA_Q, D_MODEL), SWA_Q),
        'sinks': 0.5 * jax.random.normal(ks[8], (L, SWA_HEADS), f32),
        'w_out': nrm(ks[9], (L, D_MODEL, D_MODEL), D_MODEL, DEEPNORM_BETA),
        'ln1_g': gain(ks[10], (L, D_MODEL)),
        'ln1_b': bias(ks[11], (L, D_MODEL)),
        'w_ffn_gate': nrm(ks[12], (L, D_MODEL, D_FF), D_MODEL),
        'w_ffn_up': nrm(ks[13], (L, D_MODEL, D_FF), D_MODEL),
        'w_ffn_down': nrm(ks[14], (L, D_FF, D_MODEL), D_FF, DEEPNORM_BETA),
        'ln2_g': gain(ks[15], (L, D_MODEL)),
        'ln2_b': bias(ks[16], (L, D_MODEL)),
    }


def reference(x, positions, w_in, w_decay_up, b_decay, gla_norm_g, w_branch_a, w_branch_b,
              sinks, w_out, ln1_g, ln1_b, w_ffn_gate, w_ffn_up, w_ffn_down, ln2_g, ln2_b):
    h = x
    for layer in range(DEPTH):
        mix = hybrid_mixer(h, positions, w_in[layer], w_decay_up[layer], b_decay[layer],
                           gla_norm_g[layer], w_branch_a[layer], w_branch_b[layer],
                           sinks[layer], w_out[layer])
        h = layer_norm(DEEPNORM_ALPHA * h + mix, ln1_g[layer], ln1_b[layer])
        ffn = swiglu_ffn(h, w_ffn_gate[layer], w_ffn_up[layer], w_ffn_down[layer])
        h = layer_norm(DEEPNORM_ALPHA * h + ffn, ln2_g[layer], ln2_b[layer])
    return h
```

```cpp
#include <hip/hip_runtime.h>
#include <cstdio>
#include <cstdint>
#include <cmath>
namespace pg8 {
#define PG8_LAS __attribute__((address_space(3)))
typedef unsigned short bf16_t;
typedef short bf16x8 __attribute__((ext_vector_type(8)));
typedef float f32x4 __attribute__((ext_vector_type(4)));
typedef unsigned u32x4 __attribute__((ext_vector_type(4)));
constexpr int BM = 256, BK = 64, HALF = 128, HTB = HALF * BK * 2  , STAGE_BYTES = 8 * HTB, NXCD = 8, WGM = 8;

__host__ __device__ __forceinline__ int lds_byte(int r, int c) { const int st = (r >> 4) * 2 + (c >> 5), rr = r & 15, cc = c & 31, ob = rr * 64 + cc * 2; return st * 1024 + (ob ^ (((ob >> 9) & 1) << 5)); }
__host__ __device__ __forceinline__ void stage_rc(int b, int& R, int& C) { const int st = b / 1024, sb = b % 1024, swz = sb ^ (((sb >> 9) & 1) << 5); R = (st >> 1) * 16 + swz / 64; C = (st & 1) * 32 + (swz % 64) / 2; }
__host__ __device__ __forceinline__ int perm32(int rho) { const int n = rho >> 4, i = rho & 15; return 8 * (i >> 2) + 4 * n + (i & 3); }

struct Unit { int pm, pn; };
struct Gemm { const bf16_t* A; const bf16_t* Bt; int M, N, K, lda, ldb; };

struct StaticOrder {
    int nM, nN, nwg, G, c;
    __host__ __device__ void init(int M, int N, int G_, int c_) { nM = M / BM; nN = N / BM; nwg = nM * nN; G = G_; c = c_; }
    __host__ __device__ bool next(int i, Unit& u) const {
        const long L = (long)i * G + c; if (L >= nwg) return false;
        int wgid = (int)L; { const int q = nwg / NXCD, r = nwg % NXCD, xcd = wgid % NXCD, off = wgid / NXCD; wgid = (xcd < r ? xcd * (q + 1) : r * (q + 1) + (xcd - r) * q) + off; }
        const int nig = WGM * nN, gid = wgid / nig, fm = gid * WGM, gsz = (nM - fm) < WGM ? (nM - fm) : WGM;
        u.pm = fm + ((wgid % nig) % gsz); u.pn = (wgid % nig) / gsz; return true;
    }
    __device__ __forceinline__ void a_ready(const Unit&) const {}
    __device__ __forceinline__ void done(const Unit&) const {}
};
__device__ __forceinline__ unsigned cvt_pk_bf16(float lo, float hi) { unsigned r; asm volatile("v_cvt_pk_bf16_f32 %0, %1, %2" : "=v"(r) : "v"(lo), "v"(hi)); return r; }
__device__ __forceinline__ float bf_lo(unsigned w) { return __uint_as_float(w << 16); }
__device__ __forceinline__ float bf_hi(unsigned w) { return __uint_as_float(w & 0xffff0000u); }
__device__ __forceinline__ float sigm(float x) { return __builtin_amdgcn_rcpf(1.f + __expf(-x)); }

struct EpiProj {
    static constexpr bool PERM = true, AFTER_DRAIN = false;
    bf16_t *QA, *KA, *VA, *RA, *QB, *KVB, *GAB; float* DLOW;
    __device__ __forceinline__ void operator()(const f32x4 (&acc)[2][2][4][2], const Unit& u, int wr, int wc, int fr, int fq) const {
        const int pn = u.pn; const int row0 = u.pm * BM + wr * 64 + fr;
        if (pn == 25) {
            if (wc == 0 && fq < 2) {
#pragma unroll
                for (int ai = 0; ai < 2; ++ai)
#pragma unroll
                    for (int m = 0; m < 4; ++m) { float* p = DLOW + (size_t)(row0 + ai * HALF + m * 16) * 16 + 8 * fq; *(f32x4*)p = acc[ai][0][m][0]; *(f32x4*)(p + 4) = acc[ai][0][m][1]; }
            }
            return;
        }
        bf16_t* base; int ldc, colt; float sc = 1.f;
        if (pn < 2)       { base = QA;  ldc = 512;  colt = pn * 256; sc = 0.08838834764831845f; }
        else if (pn < 4)  { base = KA;  ldc = 512;  colt = (pn - 2) * 256; }
        else if (pn < 8)  { base = VA;  ldc = 1024; colt = (pn - 4) * 256; }
        else if (pn < 12) { base = RA;  ldc = 1024; colt = (pn - 8) * 256; }
        else if (pn < 16) { base = QB;  ldc = 1024; colt = (pn - 12) * 256; }
        else if (pn == 16){ base = KVB; ldc = 256;  colt = 0; }
        else              { base = GAB; ldc = 2048; colt = (pn - 17) * 256; }
        const int col0 = colt + wc * 32 + 8 * fq;
#pragma unroll
        for (int ai = 0; ai < 2; ++ai)
#pragma unroll
            for (int m = 0; m < 4; ++m) { bf16_t* rowp = base + (size_t)(row0 + ai * HALF + m * 16) * ldc + col0;
#pragma unroll
                for (int bj = 0; bj < 2; ++bj) { const f32x4 v0 = acc[ai][bj][m][0] * sc, v1 = acc[ai][bj][m][1] * sc;
                    u32x4 w; w.x = cvt_pk_bf16(v0[0], v0[1]); w.y = cvt_pk_bf16(v0[2], v0[3]); w.z = cvt_pk_bf16(v1[0], v1[1]); w.w = cvt_pk_bf16(v1[2], v1[3]);
                    *(u32x4*)(rowp + bj * HALF) = w; } }
    }
};
struct EpiMergeA {
    static constexpr bool PERM = true, AFTER_DRAIN = false;
    float* T1; const bf16_t* G;
    __device__ __forceinline__ void operator()(const f32x4 (&acc)[2][2][4][2], const Unit& u, int wr, int wc, int fr, int fq) const {
        const int row0 = u.pm * BM + wr * 64 + fr, col0 = u.pn * BM + wc * 32 + 8 * fq;
#pragma unroll
        for (int ai = 0; ai < 2; ++ai)
#pragma unroll
            for (int m = 0; m < 4; ++m) { const size_t row = (size_t)(row0 + ai * HALF + m * 16);
#pragma unroll
                for (int bj = 0; bj < 2; ++bj) { const int c = col0 + bj * HALF; const u32x4 g = *(const u32x4*)(G + row * 2048 + c);
                    f32x4 v0 = acc[ai][bj][m][0], v1 = acc[ai][bj][m][1];
                    v0[0] *= sigm(bf_lo(g.x)); v0[1] *= sigm(bf_hi(g.x)); v0[2] *= sigm(bf_lo(g.y)); v0[3] *= sigm(bf_hi(g.y));
                    v1[0] *= sigm(bf_lo(g.z)); v1[1] *= sigm(bf_hi(g.z)); v1[2] *= sigm(bf_lo(g.w)); v1[3] *= sigm(bf_hi(g.w));
                    *(f32x4*)(T1 + row * 1024 + c) = v0; *(f32x4*)(T1 + row * 1024 + c + 4) = v1; } }
    }
};
struct EpiMergeB {
    static constexpr bool PERM = true, AFTER_DRAIN = false;
    const float* T1; const bf16_t* G; bf16_t* MG;
    __device__ __forceinline__ void operator()(const f32x4 (&acc)[2][2][4][2], const Unit& u, int wr, int wc, int fr, int fq) const {
        const int row0 = u.pm * BM + wr * 64 + fr, col0 = u.pn * BM + wc * 32 + 8 * fq;
#pragma unroll
        for (int ai = 0; ai < 2; ++ai)
#pragma unroll
            for (int m = 0; m < 4; ++m) { const size_t row = (size_t)(row0 + ai * HALF + m * 16);
#pragma unroll
                for (int bj = 0; bj < 2; ++bj) { const int c = col0 + bj * HALF; const u32x4 g = *(const u32x4*)(G + row * 2048 + c);
                    f32x4 v0 = acc[ai][bj][m][0], v1 = acc[ai][bj][m][1]; const f32x4 t0 = *(const f32x4*)(T1 + row * 1024 + c), t1 = *(const f32x4*)(T1 + row * 1024 + c + 4);
                    v0[0] = t0[0] + v0[0] * sigm(bf_lo(g.x)); v0[1] = t0[1] + v0[1] * sigm(bf_hi(g.x)); v0[2] = t0[2] + v0[2] * sigm(bf_lo(g.y)); v0[3] = t0[3] + v0[3] * sigm(bf_hi(g.y));
                    v1[0] = t1[0] + v1[0] * sigm(bf_lo(g.z)); v1[1] = t1[1] + v1[1] * sigm(bf_hi(g.z)); v1[2] = t1[2] + v1[2] * sigm(bf_lo(g.w)); v1[3] = t1[3] + v1[3] * sigm(bf_hi(g.w));
                    u32x4 w; w.x = cvt_pk_bf16(v0[0], v0[1]); w.y = cvt_pk_bf16(v0[2], v0[3]); w.z = cvt_pk_bf16(v1[0], v1[1]); w.w = cvt_pk_bf16(v1[2], v1[3]);
                    *(u32x4*)(MG + row * 1024 + c) = w; } }
    }
};
struct EpiPreLN {
    static constexpr bool PERM = false, AFTER_DRAIN = false;
    const float* base; float* out; float alpha;
    __device__ __forceinline__ void operator()(const f32x4 (&acc)[2][2][4][2], const Unit& u, int wr, int wc, int fr, int fq) const {
        const int row0 = u.pm * BM + wr * 64 + fr, col0 = u.pn * BM + wc * 32 + 4 * fq;
#pragma unroll
        for (int ai = 0; ai < 2; ++ai)
#pragma unroll
            for (int m = 0; m < 4; ++m) { const size_t off = (size_t)(row0 + ai * HALF + m * 16) * 1024 + col0;
#pragma unroll
                for (int bj = 0; bj < 2; ++bj)
#pragma unroll
                    for (int n = 0; n < 2; ++n) { const f32x4 b = *(const f32x4*)(base + off + bj * HALF + n * 16); *(f32x4*)(out + off + bj * HALF + n * 16) = b * alpha + acc[ai][bj][m][n]; } }
    }
};
struct EpiSwiGLU {
    static constexpr bool PERM = true, AFTER_DRAIN = false;
    bf16_t* FH;
    __device__ __forceinline__ void operator()(const f32x4 (&acc)[2][2][4][2], const Unit& u, int wr, int wc, int fr, int fq) const {
        const int row0 = u.pm * BM + wr * 64 + fr, col0 = u.pn * HALF + wc * 32 + 8 * fq;
#pragma unroll
        for (int ai = 0; ai < 2; ++ai)
#pragma unroll
            for (int m = 0; m < 4; ++m) { bf16_t* rowp = FH + (size_t)(row0 + ai * HALF + m * 16) * 2816 + col0;
                f32x4 v0, v1;
#pragma unroll
                for (int i = 0; i < 4; ++i) { const float g0 = acc[ai][0][m][0][i], g1 = acc[ai][0][m][1][i]; v0[i] = g0 * sigm(g0) * acc[ai][1][m][0][i]; v1[i] = g1 * sigm(g1) * acc[ai][1][m][1][i]; }
                u32x4 w; w.x = cvt_pk_bf16(v0[0], v0[1]); w.y = cvt_pk_bf16(v0[2], v0[3]); w.z = cvt_pk_bf16(v1[0], v1[1]); w.w = cvt_pk_bf16(v1[2], v1[3]);
                *(u32x4*)rowp = w; }
    }
};

template <class Epi, class Sched, bool ALIGN_EPI = false, bool SP2 = false>
__device__ __forceinline__ void gemm_phase(PG8_LAS unsigned char* lds, const Gemm g, const Sched& S, const Epi& E) {
    const int tid = threadIdx.x, wid = __builtin_amdgcn_readfirstlane(tid >> 6), lane = tid & 63, wr = wid >> 2, wc = wid & 3, fr = lane & 15, fq = lane >> 4;
    const int K = g.K, nt = K / BK, lda = g.lda, ldb = g.ldb;
    unsigned voffA[2], voffB[2];
#pragma unroll
    for (int i = 0; i < 2; ++i) { int R, C; stage_rc(tid * 16 + i * 8192, R, C); const int Rb = Epi::PERM ? ((R & ~31) + perm32(R & 31)) : R;
        voffA[i] = (unsigned)(R * lda + C) * 2u; voffB[i] = (unsigned)(Rb * ldb + C) * 2u; }
    const size_t kstep = (size_t)(BK * 2);
    const size_t hstepA = (size_t)HALF * lda * 2, hstepB = (size_t)HALF * ldb * 2;
    const size_t tstepA = 2 * hstepA, tstepB = 2 * hstepB;
    const unsigned ldsw = (unsigned)wid * 1024u;
    const int aoff = lds_byte(wr * 64 + fr, fq * 8), boff = lds_byte(wc * 32 + fr, fq * 8);
#define PG8_SA(b, h) (((b) * 2 + (h)) * HTB)
#define PG8_SB(b, h) ((4 + (b) * 2 + (h)) * HTB)
#define PG8_STAGE(bufoff, gbase, voff) do { _Pragma("unroll") for (int _i = 0; _i < 2; ++_i) \
        __builtin_amdgcn_global_load_lds((const unsigned*)((const char*)(gbase) + (voff)[_i]), (PG8_LAS unsigned*)(lds + (bufoff) + ldsw + _i * 8192), 16, 0, 0); } while (0)
#define PG8_LDA(dst, b, h) do { _Pragma("unroll") for (int m = 0; m < 4; ++m) _Pragma("unroll") for (int k = 0; k < 2; ++k) dst[m][k] = *(const PG8_LAS bf16x8*)(lds + PG8_SA(b, h) + aoff + m * 2048 + k * 1024); } while (0)
#define PG8_LDB(dst, b, h) do { _Pragma("unroll") for (int n = 0; n < 2; ++n) _Pragma("unroll") for (int k = 0; k < 2; ++k) dst[n][k] = *(const PG8_LAS bf16x8*)(lds + PG8_SB(b, h) + boff + n * 2048 + k * 1024); } while (0)
#define PG8_MMA(ai, bj, At, Bt) do { __builtin_amdgcn_s_setprio(1); _Pragma("unroll") for (int m = 0; m < 4; ++m) _Pragma("unroll") for (int n = 0; n < 2; ++n) _Pragma("unroll") for (int k = 0; k < 2; ++k) \
        acc[ai][bj][m][n] = __builtin_amdgcn_mfma_f32_16x16x32_bf16(Bt[n][k], At[m][k], acc[ai][bj][m][n], 0, 0, 0); __builtin_amdgcn_s_setprio(0); } while (0)
#define PG8_WAIT_V(n) asm volatile("s_waitcnt vmcnt(" #n ")" ::: "memory")
#define PG8_WAIT_L(n) asm volatile("s_waitcnt lgkmcnt(" #n ")" ::: "memory")
#define PG8_BAR __builtin_amdgcn_s_barrier()
#define PG8_SCHED __builtin_amdgcn_sched_barrier(0)
    Unit cur, nxt; int ui = 0;
    if (!S.next(0, cur)) return;
    f32x4 acc[2][2][4][2];
#pragma unroll
    for (int a = 0; a < 2; ++a)
#pragma unroll
        for (int b = 0; b < 2; ++b)
#pragma unroll
            for (int m = 0; m < 4; ++m)
#pragma unroll
                for (int n = 0; n < 2; ++n) acc[a][b][m][n] = (f32x4){0.f, 0.f, 0.f, 0.f};
    bf16x8 At[4][2], B0[2][2], B1[2][2];
    const char* cA = (const char*)g.A + (size_t)cur.pm * tstepA; const char* cB = (const char*)g.Bt + (size_t)cur.pn * tstepB;
    S.a_ready(cur);
    if constexpr (SP2) {
        PG8_STAGE(PG8_SB(0, 0), cB, voffB); PG8_STAGE(PG8_SB(0, 1), cB + hstepB, voffB); PG8_STAGE(PG8_SA(0, 0), cA, voffA); PG8_STAGE(PG8_SA(0, 1), cA + hstepA, voffA);
        if (wr == 1) PG8_BAR;
        PG8_WAIT_V(2); PG8_BAR;
        PG8_STAGE(PG8_SB(1, 0), cB + kstep, voffB); PG8_STAGE(PG8_SA(1, 0), cA + kstep, voffA); PG8_STAGE(PG8_SB(1, 1), cB + hstepB + kstep, voffB);
        PG8_WAIT_V(6); PG8_BAR;
    } else {
        PG8_STAGE(PG8_SB(0, 0), cB, voffB); PG8_STAGE(PG8_SA(0, 0), cA, voffA); PG8_STAGE(PG8_SB(0, 1), cB + hstepB, voffB); PG8_STAGE(PG8_SA(0, 1), cA + hstepA, voffA);
        if (wr == 1) PG8_BAR;
        PG8_WAIT_V(4); PG8_BAR;
        PG8_STAGE(PG8_SB(1, 0), cB + kstep, voffB); PG8_STAGE(PG8_SA(1, 0), cA + kstep, voffA); PG8_STAGE(PG8_SB(1, 1), cB + hstepB + kstep, voffB);
        PG8_WAIT_V(6); PG8_BAR;
    }
    for (;;) {
        const bool has_next = S.next(ui + 1, nxt);
        const char* nA = has_next ? (const char*)g.A + (size_t)nxt.pm * tstepA : cA; const char* nB = has_next ? (const char*)g.Bt + (size_t)nxt.pn * tstepB : cB;
        for (int t = 0; t < nt; t += 2) {
            const bool last = (t == nt - 2);
            const char* a1 = cA + (size_t)(t + 1) * kstep;
            const char* a2 = last ? nA : cA + (size_t)(t + 2) * kstep; const char* b2 = last ? nB : cB + (size_t)(t + 2) * kstep;
            const char* a3 = a2 + kstep; const char* b3 = b2 + kstep;
            if (last && has_next) S.a_ready(nxt);
            if constexpr (SP2) {
            PG8_LDB(B0, 0, 0); PG8_LDB(B1, 0, 1); PG8_SCHED; PG8_LDA(At, 0, 0); PG8_STAGE(PG8_SA(1, 1), a1 + hstepA, voffA);
            PG8_WAIT_V(8); PG8_WAIT_L(0); PG8_BAR; PG8_MMA(0, 0, At, B0); PG8_MMA(0, 1, At, B1); PG8_BAR; PG8_SCHED;
            PG8_LDA(At, 0, 1); PG8_STAGE(PG8_SB(0, 0), b2, voffB); PG8_STAGE(PG8_SB(0, 1), b2 + hstepB, voffB); PG8_STAGE(PG8_SA(0, 0), a2, voffA);
            PG8_WAIT_V(8); PG8_WAIT_L(0); PG8_BAR; PG8_MMA(1, 0, At, B0); PG8_MMA(1, 1, At, B1); PG8_BAR; PG8_SCHED;
            PG8_LDB(B0, 1, 0); PG8_LDB(B1, 1, 1); PG8_SCHED; PG8_LDA(At, 1, 0); PG8_STAGE(PG8_SA(0, 1), a2 + hstepA, voffA);
            PG8_WAIT_V(8); PG8_WAIT_L(0); PG8_BAR; PG8_MMA(0, 0, At, B0); PG8_MMA(0, 1, At, B1); PG8_BAR; PG8_SCHED;
            PG8_LDA(At, 1, 1); PG8_STAGE(PG8_SB(1, 0), b3, voffB); PG8_STAGE(PG8_SB(1, 1), b3 + hstepB, voffB); PG8_STAGE(PG8_SA(1, 0), a3, voffA);
            PG8_WAIT_V(8); PG8_WAIT_L(0); PG8_BAR; PG8_MMA(1, 0, At, B0); PG8_MMA(1, 1, At, B1); PG8_BAR; PG8_SCHED;
            } else {
            PG8_LDB(B0, 0, 0); PG8_SCHED; PG8_LDA(At, 0, 0); PG8_STAGE(PG8_SA(1, 1), a1 + hstepA, voffA);
            PG8_WAIT_L(8); PG8_BAR; PG8_WAIT_L(0); PG8_MMA(0, 0, At, B0); PG8_BAR; PG8_SCHED;
            PG8_LDB(B1, 0, 1); PG8_STAGE(PG8_SB(0, 0), b2, voffB);
            PG8_BAR; PG8_WAIT_L(0); PG8_MMA(0, 1, At, B1); PG8_BAR;
            PG8_LDA(At, 0, 1); PG8_STAGE(PG8_SA(0, 0), a2, voffA);
            PG8_BAR; PG8_WAIT_L(0); PG8_MMA(1, 0, At, B0); PG8_BAR; PG8_SCHED;
            PG8_STAGE(PG8_SB(0, 1), b2 + hstepB, voffB);
            PG8_WAIT_V(6); PG8_BAR; PG8_MMA(1, 1, At, B1); PG8_BAR;
            PG8_LDB(B0, 1, 0); PG8_SCHED; PG8_LDA(At, 1, 0); PG8_STAGE(PG8_SA(0, 1), a2 + hstepA, voffA);
            PG8_WAIT_L(8); PG8_BAR; PG8_WAIT_L(0); PG8_MMA(0, 0, At, B0); PG8_BAR; PG8_SCHED;
            PG8_LDB(B1, 1, 1); PG8_STAGE(PG8_SB(1, 0), b3, voffB);
            PG8_BAR; PG8_WAIT_L(0); PG8_MMA(0, 1, At, B1); PG8_BAR;
            PG8_LDA(At, 1, 1); PG8_STAGE(PG8_SA(1, 0), a3, voffA);
            PG8_BAR; PG8_WAIT_L(0); PG8_MMA(1, 0, At, B0); PG8_BAR; PG8_SCHED;
            PG8_STAGE(PG8_SB(1, 1), b3 + hstepB, voffB);
            PG8_WAIT_V(6); PG8_BAR; PG8_MMA(1, 1, At, B1); PG8_BAR;
            }
        }
        if constexpr (ALIGN_EPI) { if (wr == 0) PG8_BAR; }
        if constexpr (!Epi::AFTER_DRAIN) { E(acc, cur, wr, wc, fr, fq); S.done(cur); }
        if (!has_next) break;
#pragma unroll
        for (int a = 0; a < 2; ++a)
#pragma unroll
            for (int b = 0; b < 2; ++b)
#pragma unroll
                for (int m = 0; m < 4; ++m)
#pragma unroll
                    for (int n = 0; n < 2; ++n) acc[a][b][m][n] = (f32x4){0.f, 0.f, 0.f, 0.f};
        cur = nxt; cA = nA; cB = nB; ++ui;
        if constexpr (ALIGN_EPI) { if (wr == 1) PG8_BAR; }
    }
    PG8_WAIT_V(0);
    if constexpr (!ALIGN_EPI) { if (wr == 0) PG8_BAR; }
    PG8_BAR;
    if constexpr (Epi::AFTER_DRAIN) { E.fused(acc, cur, wr, wc, fr, fq, lds, wid, lane); S.done(cur); }
#undef PG8_SA
#undef PG8_SB
#undef PG8_STAGE
#undef PG8_LDA
#undef PG8_LDB
#undef PG8_MMA
#undef PG8_WAIT_V
#undef PG8_WAIT_L
#undef PG8_BAR
#undef PG8_SCHED
}
}

constexpr int NWAVES = 8;
#ifndef MK_N_LAUNCHES
#define MK_N_LAUNCHES 1
#endif
constexpr int NPHASE = 10;
constexpr int BATCH = 8, T = 4096, D = 1024, M = BATCH * T;
constexpr int NPROJ = 6656;
constexpr int DFF = 2816, NGU = 2 * DFF;
constexpr float LN_EPS = 1e-5f, RMS_EPS = 1e-6f, DN_ALPHA = 1.189207115002721f;
constexpr size_t MiB = 1u << 20;
constexpr size_t WS_CTL = 0, CTL_ZERO_BYTES = 1 * MiB;
constexpr size_t WS_WIN = 1 * MiB, WS_WAB = 14 * MiB, WS_WOUT = 18 * MiB, WS_WGU = 20 * MiB, WS_WD = 31 * MiB;
constexpr size_t WS_ROPE = 37 * MiB, WS_DLOW = 39 * MiB;
constexpr size_t WS_XB = 42 * MiB;
constexpr size_t WS_QA = 106 * MiB, WS_KA = 138 * MiB, WS_VA = 170 * MiB, WS_RA = 234 * MiB, WS_QB = 298 * MiB, WS_KVB = 362 * MiB;
constexpr size_t WS_OAB = 378 * MiB, WS_END = 506 * MiB;
constexpr size_t WS_T1 = 106 * MiB;
constexpr size_t WS_MG = WS_XB;
constexpr size_t WS_H1B = 106 * MiB;
constexpr size_t WS_FH = 170 * MiB;
static_assert(WS_FH + (size_t)M * DFF * 2 <= WS_KVB && WS_OAB + (size_t)M * 2048 * 2 <= WS_END, "ws map");
constexpr int CW_TMO = 0, CW_CODE = 1, CW_BAR = 4096;
constexpr int RING_OFF = 0, RING_BYTES = 131072;
constexpr int LDSCTL_OFF = RING_BYTES, MISC_OFF = LDSCTL_OFF + 320;
constexpr int LDS_BYTES = 147456;

#define GAS __attribute__((address_space(1)))
#define LAS __attribute__((address_space(3)))
typedef unsigned short bf16;
typedef unsigned v4u __attribute__((ext_vector_type(4)));
typedef unsigned v2u __attribute__((ext_vector_type(2)));
typedef float f32x4 __attribute__((ext_vector_type(4)));
typedef GAS unsigned gu32;
#define RLX_AGENT __ATOMIC_RELAXED, __HIP_MEMORY_SCOPE_AGENT
#define LDS_WAIT() asm volatile("s_waitcnt lgkmcnt(0)" ::: "memory")
#define VM_WAIT() asm volatile("s_waitcnt vmcnt(0)" ::: "memory")
__device__ __forceinline__ unsigned f2bf(float f) { unsigned u = __builtin_bit_cast(unsigned, f); return (u + 0x7fffu + ((u >> 16) & 1u)) >> 16; }
__device__ __forceinline__ unsigned pk2(float lo, float hi) { return f2bf(lo) | (f2bf(hi) << 16); }
__device__ __forceinline__ float bf2f(bf16 v) { return __uint_as_float((unsigned)v << 16); }
using pg8::bf_lo; using pg8::bf_hi; using pg8::sigm;

#define XB_TMO      128
#define XB_XCNT(j)  (256  + 64 * (j))
#define XB_XSUB(j)  (1280 + 64 * (j))
#define XB_XGEN(j)  (2304 + 64 * (j))
#define XB_TOP      3328
#define XB_TOPGEN   3392
#define XCD_BAR_WORDS 3456
#define XB_SPIN_CAP (1u << 18)

__device__ __forceinline__ unsigned xb_ld(unsigned* p)              { return __hip_atomic_load(p, __ATOMIC_RELAXED, __HIP_MEMORY_SCOPE_AGENT); }
__device__ __forceinline__ unsigned xb_add(unsigned* p, unsigned v) { return __hip_atomic_fetch_add(p, v, __ATOMIC_RELAXED, __HIP_MEMORY_SCOPE_AGENT); }
__device__ __forceinline__ unsigned xb_xcc_id() { return (unsigned)__builtin_amdgcn_s_getreg((3 << 11) | 20) & 0xFu; }
#define XB_SPIN(cond, bar) do { unsigned _sp = 0; while (cond) { __builtin_amdgcn_s_sleep(1); \
    if ((++_sp & 255u) == 0u) { if (xb_ld(&(bar)[XB_TMO])) break; if (_sp > XB_SPIN_CAP) { atomicAdd(&(bar)[XB_TMO], 1u); break; } } } } while (0)

struct XcdBarrier {
    unsigned* bar; unsigned x;
    volatile LAS unsigned* st;
};

__device__ __forceinline__ XcdBarrier xcd_barrier_post(unsigned* bar, volatile LAS unsigned* st) {
    XcdBarrier b; b.bar = bar; b.x = xb_xcc_id(); b.st = st;
    if (threadIdx.x == 0) (void)xb_add(&bar[XB_XCNT(b.x)], 1u);
    return b;
}
__device__ __forceinline__ void xcd_barrier_complete(unsigned* bar, unsigned x, unsigned& nloc, unsigned& nx) {
    const unsigned G = gridDim.x * gridDim.y * gridDim.z;
    unsigned sum, cnt, mine, sp = 0u;
    for (;;) {
        sum = 0u; cnt = 0u; mine = 0u;
#pragma unroll
        for (unsigned j = 0; j < 16; ++j) { const unsigned c = xb_ld(&bar[XB_XCNT(j)]); sum += c; cnt += (c > 0u) ? 1u : 0u; mine = (j == x) ? c : mine; }
        if (sum == G) break;
        __builtin_amdgcn_s_sleep(1);
        if ((++sp & 255u) == 0u) { if (xb_ld(&bar[XB_TMO])) break; if (sp > XB_SPIN_CAP) { atomicAdd(&bar[XB_TMO], 1u); break; } }
    }
    nloc = mine > 0u ? mine : 1u; nx = cnt > 0u ? cnt : 1u;
}

__device__ __forceinline__ void xcd_barrier(const XcdBarrier& b) {
    asm volatile("s_waitcnt vmcnt(0)" ::: "memory");
    __syncthreads();
    if (threadIdx.x == 0) {
        unsigned* bar = b.bar;
        __builtin_amdgcn_s_waitcnt(0);
        unsigned nloc = b.st[0], nx = b.st[1];
        if (nloc == 0u) { xcd_barrier_complete(bar, b.x, nloc, nx); b.st[0] = nloc; b.st[1] = nx; }
        const unsigned old = xb_add(&bar[XB_XSUB(b.x)], 1u);
        const unsigned gen = old / nloc;
        if (old + 1u == (gen + 1u) * nloc) {
            __builtin_amdgcn_fence(__ATOMIC_RELEASE, "agent");
            asm volatile("s_waitcnt vmcnt(0)" ::: "memory");
            const unsigned og = xb_add(&bar[XB_TOP], 1u);
            const unsigned tg = og / nx;
            if (og + 1u == (tg + 1u) * nx) xb_add(&bar[XB_TOPGEN], 1u);
            else XB_SPIN(xb_ld(&bar[XB_TOPGEN]) == tg, bar);
            __builtin_amdgcn_fence(__ATOMIC_ACQUIRE, "agent");
            xb_add(&bar[XB_XGEN(b.x)], 1u);
            asm volatile("s_waitcnt vmcnt(0)" ::: "memory");
        } else {
            XB_SPIN(xb_ld(&bar[XB_XGEN(b.x)]) == gen, bar);
            __builtin_amdgcn_fence(__ATOMIC_ACQUIRE, "agent");
            asm volatile("s_waitcnt vmcnt(0)" ::: "memory");
        }
    }
    __syncthreads();
}

struct Frame {
    LAS unsigned char* lds;
    volatile LAS unsigned* MISC;
    gu32* ctl;
    int tid, lane, wave, vcu, G;
    const float* x; const int* pos; const float *w_in, *w_du, *b_dec, *gn_g, *w_a, *w_b, *sinks, *w_out, *ln1g, *ln1b, *w_g, *w_u, *w_d, *ln2g, *ln2b;
    float* out; unsigned char* ws;
};
__device__ __forceinline__ float wave_sum(float v) {
#pragma unroll
    for (int o = 1; o < 64; o <<= 1) v += __shfl_xor(v, o);
    return v;
}
__device__ __forceinline__ float wave_max(float v) {
#pragma unroll
    for (int o = 1; o < 64; o <<= 1) v = fmaxf(v, __shfl_xor(v, o));
    return v;
}
__device__ __forceinline__ void tr_item(const float* W, int ldsrc, int k0, int sn0, int nvalid, bf16* WT, int ldd, int dn0, int dk0, LAS float* scr, int lane) {
#pragma unroll 8
    for (int i = 0; i < 32; ++i) { const int kk = 2 * i + (lane >> 5), n = lane & 31; float v = 0.f; if (sn0 >= 0 && n < nvalid) v = W[(size_t)(k0 + kk) * ldsrc + sn0 + n]; scr[kk * 33 + n] = v; }
    LDS_WAIT(); asm volatile("" ::: "memory");
    const int c = lane & 7;
#pragma unroll
    for (int j = 0; j < 4; ++j) { const int n = (lane >> 3) + 8 * j; const LAS float* s = scr + (8 * c) * 33 + n;
        v4u o; o.x = pk2(s[0 * 33], s[1 * 33]); o.y = pk2(s[2 * 33], s[3 * 33]); o.z = pk2(s[4 * 33], s[5 * 33]); o.w = pk2(s[6 * 33], s[7 * 33]);
        *(GAS v4u*)(WT + (size_t)(dn0 + n) * ldd + dk0 + k0 + 8 * c) = o; }
    LDS_WAIT(); asm volatile("" ::: "memory");
}
__device__ __forceinline__ void p0_prologue(Frame& F) {
    LAS float* scr = (LAS float*)(F.lds + RING_OFF + F.wave * 16384);
    const int gw = F.vcu * NWAVES + F.wave, NGW = F.G * NWAVES;
    bf16* WIN_t = (bf16*)(F.ws + WS_WIN); bf16* WAB_t = (bf16*)(F.ws + WS_WAB); bf16* WOUT_t = (bf16*)(F.ws + WS_WOUT); bf16* WGU_t = (bf16*)(F.ws + WS_WGU); bf16* WD_t = (bf16*)(F.ws + WS_WD);
    constexpr int I_IN = 16 * 208, I_SQ = 16 * 32, I_FF = 16 * 88, I_DN = 44 * 32;
    constexpr int NITEMS = I_IN + 3 * I_SQ + 2 * I_FF + I_DN;
    for (int it = gw; it < NITEMS; it += NGW) {
        int r = it;
        if (r < I_IN) { const int kb = r / 208, nb = r % 208, dn0 = 32 * nb; int sn0, nv = 32;
            if (dn0 < 3072) sn0 = dn0; else if (dn0 < 6400) sn0 = dn0 + 16; else if (dn0 == 6400) { sn0 = 3072; nv = 16; } else sn0 = -1;
            tr_item(F.w_in, 6416, 64 * kb, sn0, nv, WIN_t, 1024, dn0, 0, scr, F.lane); continue; } r -= I_IN;
        if (r < I_SQ) { tr_item(F.w_a, 1024, 64 * (r / 32), 32 * (r % 32), 32, WAB_t, 2048, 32 * (r % 32), 0, scr, F.lane); continue; } r -= I_SQ;
        if (r < I_SQ) { tr_item(F.w_b, 1024, 64 * (r / 32), 32 * (r % 32), 32, WAB_t, 2048, 32 * (r % 32), 1024, scr, F.lane); continue; } r -= I_SQ;
        if (r < I_SQ) { tr_item(F.w_out, 1024, 64 * (r / 32), 32 * (r % 32), 32, WOUT_t, 1024, 32 * (r % 32), 0, scr, F.lane); continue; } r -= I_SQ;
        if (r < I_FF) { const int sn0 = 32 * (r % 88); tr_item(F.w_g, DFF, 64 * (r / 88), sn0, 32, WGU_t, 1024, 256 * (sn0 / 128) + (sn0 % 128), 0, scr, F.lane); continue; } r -= I_FF;
        if (r < I_FF) { const int sn0 = 32 * (r % 88); tr_item(F.w_u, DFF, 64 * (r / 88), sn0, 32, WGU_t, 1024, 256 * (sn0 / 128) + 128 + (sn0 % 128), 0, scr, F.lane); continue; } r -= I_FF;
        tr_item(F.w_d, 1024, 64 * (r / 32), 32 * (r % 32), 32, WD_t, DFF, 32 * (r % 32), 0, scr, F.lane);
    }
    bf16* XB = (bf16*)(F.ws + WS_XB);
    for (int m = gw; m < M; m += NGW) {
        const GAS f32x4* xr = (const GAS f32x4*)(F.x + (size_t)m * D) + F.lane; GAS v2u* o8 = (GAS v2u*)(XB + (size_t)m * D) + F.lane;
#pragma unroll
        for (int j = 0; j < 4; ++j) { const f32x4 v = xr[64 * j]; v2u o; o.x = pk2(v.x, v.y); o.y = pk2(v.z, v.w); o8[64 * j] = o; }
    }
    float* ROPE = (float*)(F.ws + WS_ROPE);
    const int gt = F.vcu * (NWAVES * 64) + F.tid, NGT = F.G * NWAVES * 64;
    for (int i = gt; i < M * 8; i += NGT) { const int m = i >> 3, j = i & 7;
        const float invf[8] = {1.0f, 0.1939227432012558f, 0.03760603070259094f, 0.007292664609849453f, 0.0014142135623842478f, 0.00027424818836152554f, 5.3182957344688475e-05f, 1.0313385246263351e-05f};
        float fr = 1.0f;
#pragma unroll
        for (int q = 0; q < 8; ++q) if (j == q) fr = invf[q];
        const float ang = (float)F.pos[m] * fr; float s, c; sincosf(ang, &s, &c); ROPE[m * 16 + j] = c; ROPE[m * 16 + 8 + j] = s; }
}

__device__ __forceinline__ void gla_naive_unit(Frame& F, int bh) {
    const int b = bh >> 2, h = bh & 3, tid = F.tid;
    LAS float* A_l = (LAS float*)(F.lds);
    LAS bf16* Q_l = (LAS bf16*)(F.lds + 32768);
    LAS bf16* K_l = (LAS bf16*)(F.lds + 49152);
    LAS float* O_l = (LAS float*)(F.lds + 65536);
    const bf16* QA = (const bf16*)(F.ws + WS_QA); const bf16* KA = (const bf16*)(F.ws + WS_KA); const bf16* VA = (const bf16*)(F.ws + WS_VA); const bf16* RA = (const bf16*)(F.ws + WS_RA);
    const float* DLOW = (const float*)(F.ws + WS_DLOW); bf16* OAB = (bf16*)(F.ws + WS_OAB);
    const int d = tid & 127, tq = tid >> 7;
    float wd[16];
#pragma unroll
    for (int j = 0; j < 16; ++j) wd[j] = F.w_du[j * 512 + h * 128 + d];
    const float bias = F.b_dec[h * 128 + d];
    float S[128];
#pragma unroll
    for (int i = 0; i < 128; ++i) S[i] = 0.f;
    for (int ch = 0; ch < 64; ++ch) {
        const int row0 = b * T + ch * 64;
        for (int i = 0; i < 16; ++i) { const int t = 16 * tq + i; const float* dl = DLOW + (size_t)(row0 + t) * 16; float z = bias;
#pragma unroll
            for (int j = 0; j < 16; ++j) z += dl[j] * wd[j];
            const float ls = fminf(z, 0.f) - log1pf(expf(-fabsf(z)));
            A_l[t * 128 + d] = expf(ls * (1.0f / 16.0f));
            Q_l[t * 128 + d] = QA[(size_t)(row0 + t) * 512 + h * 128 + d]; K_l[t * 128 + d] = KA[(size_t)(row0 + t) * 512 + h * 128 + d]; }
        __syncthreads();
        if (tid < 256) {
            for (int t = 0; t < 64; ++t) {
                const float v = bf2f(VA[(size_t)(row0 + t) * 1024 + h * 256 + tid]); float o = 0.f;
#pragma unroll
                for (int dd = 0; dd < 128; dd += 4) { const f32x4 a4 = *(const LAS f32x4*)(A_l + t * 128 + dd); const v2u q2 = *(const LAS v2u*)(Q_l + t * 128 + dd), k2 = *(const LAS v2u*)(K_l + t * 128 + dd);
                    S[dd + 0] = a4[0] * S[dd + 0] + bf_lo(k2.x) * v; o += bf_lo(q2.x) * S[dd + 0];
                    S[dd + 1] = a4[1] * S[dd + 1] + bf_hi(k2.x) * v; o += bf_hi(q2.x) * S[dd + 1];
                    S[dd + 2] = a4[2] * S[dd + 2] + bf_lo(k2.y) * v; o += bf_lo(q2.y) * S[dd + 2];
                    S[dd + 3] = a4[3] * S[dd + 3] + bf_hi(k2.y) * v; o += bf_hi(q2.y) * S[dd + 3]; }
                O_l[t * 256 + tid] = o;
            }
        }
        __syncthreads();
        for (int i = 0; i < 8; ++i) { const int t = F.wave * 8 + i; const f32x4 o4 = *(const LAS f32x4*)(O_l + t * 256 + 4 * F.lane);
            const float ss = wave_sum(o4[0] * o4[0] + o4[1] * o4[1] + o4[2] * o4[2] + o4[3] * o4[3]); const float rstd = 1.0f / sqrtf(ss * (1.0f / 256.0f) + RMS_EPS);
            const f32x4 g4 = *(const f32x4*)(F.gn_g + 4 * F.lane); const v2u r2 = *(const v2u*)(RA + (size_t)(row0 + t) * 1024 + h * 256 + 4 * F.lane);
            const float r0 = bf_lo(r2.x), r1 = bf_hi(r2.x), r2_ = bf_lo(r2.y), r3 = bf_hi(r2.y);
            v2u w; w.x = pk2(o4[0] * rstd * g4[0] * (r0 * sigm(r0)), o4[1] * rstd * g4[1] * (r1 * sigm(r1))); w.y = pk2(o4[2] * rstd * g4[2] * (r2_ * sigm(r2_)), o4[3] * rstd * g4[3] * (r3 * sigm(r3)));
            *(v2u*)(OAB + (size_t)(row0 + t) * 2048 + h * 256 + 4 * F.lane) = w; }
        __syncthreads();
    }
}
__device__ __forceinline__ void swa_naive_unit(Frame& F, int unit) {
    const int qb = unit & 31, g = (unit >> 5) & 1, b = unit >> 6, tid = F.tid, lane = F.lane, w = F.wave;
    LAS float* Kf = (LAS float*)(F.lds);
    LAS bf16* Vb = (LAS bf16*)(F.lds + 69632);
    LAS float* q_l = (LAS float*)(F.lds + 102400) + w * 64;
    LAS float* p_l = (LAS float*)(F.lds + 104448) + w * 128;
    const bf16* QB = (const bf16*)(F.ws + WS_QB); const bf16* KVB = (const bf16*)(F.ws + WS_KVB); const float* ROPE = (const float*)(F.ws + WS_ROPE); bf16* OAB = (bf16*)(F.ws + WS_OAB);
    {
        const int j = tid >> 1, hf = tid & 1, tk = qb * 128 - 128 + j;
        float kv[32]; unsigned vv[16];
        if (tk >= 0) { const size_t row = (size_t)b * T + tk; const v4u* kp = (const v4u*)(KVB + row * 256 + g * 64 + hf * 32); const v4u* vp = (const v4u*)(KVB + row * 256 + 128 + g * 64 + hf * 32);
#pragma unroll
            for (int c = 0; c < 4; ++c) { const v4u a = kp[c], bq = vp[c];
                kv[8 * c + 0] = bf_lo(a.x); kv[8 * c + 1] = bf_hi(a.x); kv[8 * c + 2] = bf_lo(a.y); kv[8 * c + 3] = bf_hi(a.y); kv[8 * c + 4] = bf_lo(a.z); kv[8 * c + 5] = bf_hi(a.z); kv[8 * c + 6] = bf_lo(a.w); kv[8 * c + 7] = bf_hi(a.w);
                vv[4 * c + 0] = bq.x; vv[4 * c + 1] = bq.y; vv[4 * c + 2] = bq.z; vv[4 * c + 3] = bq.w; }
            if (hf == 0) { const float* rp = ROPE + row * 16;
#pragma unroll
                for (int q = 0; q < 8; ++q) { const float c = rp[q], s = rp[8 + q], x1 = kv[q], x2 = kv[8 + q]; kv[q] = x1 * c - x2 * s; kv[8 + q] = x1 * s + x2 * c; } }
        } else {
#pragma unroll
            for (int c = 0; c < 32; ++c) kv[c] = 0.f;
#pragma unroll
            for (int c = 0; c < 16; ++c) vv[c] = 0u;
        }
#pragma unroll
        for (int c = 0; c < 8; ++c) *(LAS f32x4*)(Kf + j * 68 + hf * 32 + 4 * c) = (f32x4){kv[4 * c], kv[4 * c + 1], kv[4 * c + 2], kv[4 * c + 3]};
#pragma unroll
        for (int c = 0; c < 4; ++c) *(LAS v4u*)(Vb + j * 64 + hf * 32 + 8 * c) = (v4u){vv[4 * c], vv[4 * c + 1], vv[4 * c + 2], vv[4 * c + 3]};
    }
    __syncthreads();
    const int hq = 8 * g + w; const float sink = F.sinks[hq];
    for (int qi = 0; qi < 128; ++qi) {
        const size_t row = (size_t)b * T + qb * 128 + qi;
        float qv = bf2f(QB[row * 1024 + hq * 64 + lane]);
        { const float pr = __shfl_xor(qv, 8); const float c = ROPE[row * 16 + (lane & 7)], s = ROPE[row * 16 + 8 + (lane & 7)];
          if (lane < 8) qv = qv * c - pr * s; else if (lane < 16) qv = pr * s + qv * c; }
        q_l[lane] = qv * 0.125f;
        LDS_WAIT(); asm volatile("" ::: "memory");
        const int j1 = qi + 1 + lane, j2 = qi + 65 + lane;
        float s1 = 0.f, s2 = 0.f;
#pragma unroll
        for (int dd = 0; dd < 64; dd += 4) { const f32x4 q4 = *(const LAS f32x4*)(q_l + dd), k1 = *(const LAS f32x4*)(Kf + j1 * 68 + dd), k2 = *(const LAS f32x4*)(Kf + j2 * 68 + dd);
            s1 += q4[0] * k1[0] + q4[1] * k1[1] + q4[2] * k1[2] + q4[3] * k1[3]; s2 += q4[0] * k2[0] + q4[1] * k2[1] + q4[2] * k2[2] + q4[3] * k2[3]; }
        const bool v1 = (qb > 0) || (j1 >= 128), v2 = (qb > 0) || (j2 >= 128);
        if (!v1) s1 = -INFINITY; if (!v2) s2 = -INFINITY;
        const float mx = fmaxf(wave_max(fmaxf(s1, s2)), sink);
        const float p1 = __expf(s1 - mx), p2 = __expf(s2 - mx);
        const float den = wave_sum(p1 + p2) + __expf(sink - mx);
        p_l[lane] = p1; p_l[64 + lane] = p2;
        LDS_WAIT(); asm volatile("" ::: "memory");
        float o = 0.f;
#pragma unroll 8
        for (int jj = 0; jj < 128; jj += 4) { const f32x4 p4 = *(const LAS f32x4*)(p_l + jj);
            o += p4[0] * bf2f(Vb[(qi + 1 + jj) * 64 + lane]) + p4[1] * bf2f(Vb[(qi + 2 + jj) * 64 + lane]) + p4[2] * bf2f(Vb[(qi + 3 + jj) * 64 + lane]) + p4[3] * bf2f(Vb[(qi + 4 + jj) * 64 + lane]); }
        OAB[row * 2048 + 1024 + hq * 64 + lane] = (bf16)f2bf(o / den);
        LDS_WAIT(); asm volatile("" ::: "memory");
    }
    __syncthreads();
}
__device__ __forceinline__ void ln_row(Frame& F, const float* in, float* outf, bf16* outb, const float* gam, const float* bet) {
    const GAS f32x4* xr = (const GAS f32x4*)in + F.lane;
    f32x4 v[4]; float s = 0.f;
#pragma unroll
    for (int j = 0; j < 4; ++j) { v[j] = xr[64 * j]; s += (v[j].x + v[j].y) + (v[j].z + v[j].w); }
    const float mean = wave_sum(s) * (1.f / D); float s2 = 0.f;
#pragma unroll
    for (int j = 0; j < 4; ++j) { v[j] = v[j] - mean; s2 += (v[j].x * v[j].x + v[j].y * v[j].y) + (v[j].z * v[j].z + v[j].w * v[j].w); }
    const float rstd = 1.f / sqrtf(wave_sum(s2) * (1.f / D) + LN_EPS);
#pragma unroll
    for (int j = 0; j < 4; ++j) { const f32x4 gg = *((const GAS f32x4*)gam + F.lane + 64 * j), bb = *((const GAS f32x4*)bet + F.lane + 64 * j); const f32x4 y = v[j] * rstd * gg + bb;
        *((GAS f32x4*)outf + F.lane + 64 * j) = y;
        if (outb) { v2u o; o.x = pk2(y.x, y.y); o.y = pk2(y.z, y.w); *((GAS v2u*)outb + F.lane + 64 * j) = o; } }
}

struct Args { const void* in[17]; float* out; unsigned char* ws; int ph_lo, ph_hi; };
__global__ void __launch_bounds__(NWAVES * 64, 2) mk_fwd(Args args) {
    extern __shared__ __attribute__((aligned(16))) unsigned char lds[];
    Frame F;
    F.lds = (LAS unsigned char*)lds;
    F.MISC = (volatile LAS unsigned*)(F.lds + MISC_OFF);
    F.tid = threadIdx.x; F.lane = F.tid & 63; F.wave = __builtin_amdgcn_readfirstlane(F.tid >> 6);
    F.G = gridDim.x; { const int bx = blockIdx.x; F.vcu = (F.G % 8 == 0) ? (bx % 8) * (F.G / 8) + bx / 8 : bx; }
    unsigned char* ws = args.ws; F.ws = ws; F.out = args.out;
    F.ctl = (gu32*)(ws + WS_CTL);
    F.x = (const float*)args.in[0]; F.pos = (const int*)args.in[1]; F.w_in = (const float*)args.in[2]; F.w_du = (const float*)args.in[3]; F.b_dec = (const float*)args.in[4]; F.gn_g = (const float*)args.in[5];
    F.w_a = (const float*)args.in[6]; F.w_b = (const float*)args.in[7]; F.sinks = (const float*)args.in[8]; F.w_out = (const float*)args.in[9]; F.ln1g = (const float*)args.in[10]; F.ln1b = (const float*)args.in[11];
    F.w_g = (const float*)args.in[12]; F.w_u = (const float*)args.in[13]; F.w_d = (const float*)args.in[14]; F.ln2g = (const float*)args.in[15]; F.ln2b = (const float*)args.in[16];
    for (int u = F.tid; u < (LDS_BYTES - LDSCTL_OFF) / 4; u += NWAVES * 64) ((LAS unsigned*)(F.lds + LDSCTL_OFF))[u] = 0u;
    __syncthreads();
    XcdBarrier bar; bar.bar = (unsigned*)(F.ctl + CW_BAR); bar.x = 0; bar.st = nullptr;
    if (MK_N_LAUNCHES == 1) bar = xcd_barrier_post((unsigned*)(F.ctl + CW_BAR), F.MISC + 8);
#define GRID_BAR() do { if (MK_N_LAUNCHES == 1) xcd_barrier(bar); } while (0)
    const int lo = args.ph_lo, hi = args.ph_hi;
#define IN(k) (lo <= (k) && (k) < hi)
#define BOTH(k) (IN(k) && IN((k) + 1))
    pg8::bf16_t* WIN_t = (pg8::bf16_t*)(ws + WS_WIN); pg8::bf16_t* WAB_t = (pg8::bf16_t*)(ws + WS_WAB); pg8::bf16_t* WOUT_t = (pg8::bf16_t*)(ws + WS_WOUT); pg8::bf16_t* WGU_t = (pg8::bf16_t*)(ws + WS_WGU); pg8::bf16_t* WD_t = (pg8::bf16_t*)(ws + WS_WD);
    pg8::bf16_t* XB = (pg8::bf16_t*)(ws + WS_XB); pg8::bf16_t* OAB = (pg8::bf16_t*)(ws + WS_OAB); pg8::bf16_t* MG = (pg8::bf16_t*)(ws + WS_MG); pg8::bf16_t* H1B = (pg8::bf16_t*)(ws + WS_H1B); pg8::bf16_t* FH = (pg8::bf16_t*)(ws + WS_FH);
    pg8::bf16_t* GAB = (pg8::bf16_t*)args.out;
    float* T1 = (float*)(ws + WS_T1);

    if (IN(0)) { p0_prologue(F); if (BOTH(0)) GRID_BAR(); }
    if (IN(1)) {
        pg8::Gemm g{XB, WIN_t, M, NPROJ, D, D, D}; pg8::StaticOrder S; S.init(M, NPROJ, F.G, (int)blockIdx.x);
        pg8::EpiProj E{(pg8::bf16_t*)(ws + WS_QA), (pg8::bf16_t*)(ws + WS_KA), (pg8::bf16_t*)(ws + WS_VA), (pg8::bf16_t*)(ws + WS_RA), (pg8::bf16_t*)(ws + WS_QB), (pg8::bf16_t*)(ws + WS_KVB), GAB, (float*)(ws + WS_DLOW)};
        pg8::gemm_phase<pg8::EpiProj, pg8::StaticOrder, true, true>(F.lds + RING_OFF, g, S, E);
        if (BOTH(1)) GRID_BAR();
    }
    if (IN(2)) {
        if (F.vcu < 32) gla_naive_unit(F, F.vcu);
        else for (int u = F.vcu - 32; u < 512; u += F.G - 32) swa_naive_unit(F, u);
        if (BOTH(2)) GRID_BAR();
    }
    if (IN(3)) {
        pg8::Gemm g{OAB, WAB_t, M, D, D, 2048, 2048}; pg8::StaticOrder S; S.init(M, D, F.G, (int)blockIdx.x);
        pg8::EpiMergeA E{T1, GAB};
        pg8::gemm_phase<pg8::EpiMergeA, pg8::StaticOrder, true, true>(F.lds + RING_OFF, g, S, E);
        if (BOTH(3)) GRID_BAR();
    }
    if (IN(4)) {
        pg8::Gemm g{OAB + 1024, WAB_t + 1024, M, D, D, 2048, 2048}; pg8::StaticOrder S; S.init(M, D, F.G, (int)blockIdx.x);
        pg8::EpiMergeB E{T1, GAB + 1024, MG};
        pg8::gemm_phase<pg8::EpiMergeB, pg8::StaticOrder, true, true>(F.lds + RING_OFF, g, S, E);
        if (BOTH(4)) GRID_BAR();
    }
    if (IN(5)) {
        pg8::Gemm g{MG, WOUT_t, M, D, D, D, D}; pg8::StaticOrder S; S.init(M, D, F.G, (int)blockIdx.x);
        pg8::EpiPreLN E{F.x, F.out, DN_ALPHA};
        pg8::gemm_phase<pg8::EpiPreLN, pg8::StaticOrder, true, true>(F.lds + RING_OFF, g, S, E);
        if (BOTH(5)) GRID_BAR();
    }
    if (IN(6)) {
        const int gw = F.vcu * NWAVES + F.wave, NGW = F.G * NWAVES;
        for (int m = gw; m < M; m += NGW) ln_row(F, F.out + (size_t)m * D, F.out + (size_t)m * D, (bf16*)H1B + (size_t)m * D, F.ln1g, F.ln1b);
        if (BOTH(6)) GRID_BAR();
    }
    if (IN(7)) {
        pg8::Gemm g{H1B, WGU_t, M, NGU, D, D, D}; pg8::StaticOrder S; S.init(M, NGU, F.G, (int)blockIdx.x);
        pg8::EpiSwiGLU E{FH};
        pg8::gemm_phase<pg8::EpiSwiGLU, pg8::StaticOrder, true, true>(F.lds + RING_OFF, g, S, E);
        if (BOTH(7)) GRID_BAR();
    }
    if (IN(8)) {
        pg8::Gemm g{FH, WD_t, M, D, DFF, DFF, DFF}; pg8::StaticOrder S; S.init(M, D, F.G, (int)blockIdx.x);
        pg8::EpiPreLN E{F.out, F.out, DN_ALPHA};
        pg8::gemm_phase<pg8::EpiPreLN, pg8::StaticOrder, true, true>(F.lds + RING_OFF, g, S, E);
        if (BOTH(8)) GRID_BAR();
    }
    if (IN(9)) {
        const int gw = F.vcu * NWAVES + F.wave, NGW = F.G * NWAVES;
        for (int m = gw; m < M; m += NGW) ln_row(F, F.out + (size_t)m * D, F.out + (size_t)m * D, nullptr, F.ln2g, F.ln2b);
    }
#undef IN
#undef BOTH
}

extern "C" void kernel_launch(void* const* d_in, const int* in_sizes, int n_in, void* d_out, int out_size, void* d_ws, size_t ws_size, hipStream_t stream) {
    static int grid = 0;
    if (grid == 0) {
        if (n_in != 17 || in_sizes[0] != M * D || out_size != M * D || ws_size < WS_END) { fprintf(stderr, "kernel_launch: unexpected shapes (n_in %d, in0 %d, out %d, ws %zu)\n", n_in, n_in > 0 ? in_sizes[0] : -1, out_size, ws_size); grid = -1; return; }
        int dev = 0, cus = 0, per_cu = 0;
        if (hipGetDevice(&dev) != hipSuccess || hipDeviceGetAttribute(&cus, hipDeviceAttributeMultiprocessorCount, dev) != hipSuccess) { grid = -1; return; }
        if (hipFuncSetAttribute((const void*)mk_fwd, hipFuncAttributeMaxDynamicSharedMemorySize, LDS_BYTES) != hipSuccess) { fprintf(stderr, "kernel_launch: hipFuncSetAttribute failed\n"); grid = -1; return; }
        if (hipOccupancyMaxActiveBlocksPerMultiprocessor(&per_cu, (const void*)mk_fwd, NWAVES * 64, LDS_BYTES) != hipSuccess || per_cu < 1) fprintf(stderr, "kernel_launch: occupancy query reports %d\n", per_cu);
        (void)hipGetLastError();
        grid = cus;
        if (grid != 256) fprintf(stderr, "kernel_launch: %d CUs (built for 256)\n", grid);
    }
    if (grid < 0) return;
    if (hipMemsetAsync((char*)d_ws + WS_CTL, 0, CTL_ZERO_BYTES, stream) != hipSuccess) return;
    Args a{};
    for (int i = 0; i < 17; ++i) a.in[i] = d_in[i];
    a.out = (float*)d_out; a.ws = (unsigned char*)d_ws;
    if (MK_N_LAUNCHES == 1) { a.ph_lo = 0; a.ph_hi = NPHASE; hipLaunchKernelGGL(mk_fwd, dim3(grid), dim3(NWAVES * 64), LDS_BYTES, stream, a); }
    else for (int p = 0; p < NPHASE; ++p) { a.ph_lo = p; a.ph_hi = p + 1; hipLaunchKernelGGL(mk_fwd, dim3(grid), dim3(NWAVES * 64), LDS_BYTES, stream, a); }
}
```

```cpp
#include <hip/hip_runtime.h>
#include <cstdio>
#include <cstdint>
#include <cmath>
namespace pg8 {
#define PG8_LAS __attribute__((address_space(3)))
typedef unsigned short bf16_t;
typedef short bf16x8 __attribute__((ext_vector_type(8)));
typedef float f32x4 __attribute__((ext_vector_type(4)));
typedef unsigned u32x4 __attribute__((ext_vector_type(4)));
constexpr int BM = 256, BK = 64, HALF = 128, HTB = HALF * BK * 2  , STAGE_BYTES = 8 * HTB, NXCD = 8, WGM = 8;

__host__ __device__ __forceinline__ int lds_byte(int r, int c) { const int st = (r >> 4) * 2 + (c >> 5), rr = r & 15, cc = c & 31, ob = rr * 64 + cc * 2; return st * 1024 + (ob ^ (((ob >> 9) & 1) << 5)); }
__host__ __device__ __forceinline__ void stage_rc(int b, int& R, int& C) { const int st = b / 1024, sb = b % 1024, swz = sb ^ (((sb >> 9) & 1) << 5); R = (st >> 1) * 16 + swz / 64; C = (st & 1) * 32 + (swz % 64) / 2; }
__host__ __device__ __forceinline__ int perm32(int rho) { const int n = rho >> 4, i = rho & 15; return 8 * (i >> 2) + 4 * n + (i & 3); }

struct Unit { int pm, pn; };
struct Gemm { const bf16_t* A; const bf16_t* Bt; int M, N, K, lda, ldb; };

struct StaticOrder {
    int nM, nN, nwg, G, c;
    __host__ __device__ void init(int M, int N, int G_, int c_) { nM = M / BM; nN = N / BM; nwg = nM * nN; G = G_; c = c_; }
    __host__ __device__ bool next(int i, Unit& u) const {
        const long L = (long)i * G + c; if (L >= nwg) return false;
        int wgid = (int)L; { const int q = nwg / NXCD, r = nwg % NXCD, xcd = wgid % NXCD, off = wgid / NXCD; wgid = (xcd < r ? xcd * (q + 1) : r * (q + 1) + (xcd - r) * q) + off; }
        const int nig = WGM * nN, gid = wgid / nig, fm = gid * WGM, gsz = (nM - fm) < WGM ? (nM - fm) : WGM;
        u.pm = fm + ((wgid % nig) % gsz); u.pn = (wgid % nig) / gsz; return true;
    }
    __device__ __forceinline__ void a_ready(const Unit&) const {}
    __device__ __forceinline__ void done(const Unit&) const {}
};
__device__ __forceinline__ unsigned cvt_pk_bf16(float lo, float hi) { unsigned r; asm volatile("v_cvt_pk_bf16_f32 %0, %1, %2" : "=v"(r) : "v"(lo), "v"(hi)); return r; }
__device__ __forceinline__ float bf_lo(unsigned w) { return __uint_as_float(w << 16); }
__device__ __forceinline__ float bf_hi(unsigned w) { return __uint_as_float(w & 0xffff0000u); }
__device__ __forceinline__ float sigm(float x) { return __builtin_amdgcn_rcpf(1.f + __expf(-x)); }

struct EpiProj {
    static constexpr bool PERM = true, AFTER_DRAIN = false;
    bf16_t *QA, *KA, *VA, *RA, *QB, *KVB, *GAB; float* DLOW;
    __device__ __forceinline__ void operator()(const f32x4 (&acc)[2][2][4][2], const Unit& u, int wr, int wc, int fr, int fq) const {
        const int pn = u.pn; const int row0 = u.pm * BM + wr * 64 + fr;
        if (pn == 25) {
            if (wc == 0 && fq < 2) {
#pragma unroll
                for (int ai = 0; ai < 2; ++ai)
#pragma unroll
                    for (int m = 0; m < 4; ++m) { float* p = DLOW + (size_t)(row0 + ai * HALF + m * 16) * 16 + 8 * fq; *(f32x4*)p = acc[ai][0][m][0]; *(f32x4*)(p + 4) = acc[ai][0][m][1]; }
            }
            return;
        }
        bf16_t* base; int ldc, colt; float sc = 1.f;
        if (pn < 2)       { base = QA;  ldc = 512;  colt = pn * 256; sc = 0.08838834764831845f; }
        else if (pn < 4)  { base = KA;  ldc = 512;  colt = (pn - 2) * 256; }
        else if (pn < 8)  { base = VA;  ldc = 1024; colt = (pn - 4) * 256; }
        else if (pn < 12) { base = RA;  ldc = 1024; colt = (pn - 8) * 256; }
        else if (pn < 16) { base = QB;  ldc = 1024; colt = (pn - 12) * 256; }
        else if (pn == 16){ base = KVB; ldc = 256;  colt = 0; }
        else              { base = GAB; ldc = 2048; colt = (pn - 17) * 256; }
        const int col0 = colt + wc * 32 + 8 * fq;
#pragma unroll
        for (int ai = 0; ai < 2; ++ai)
#pragma unroll
            for (int m = 0; m < 4; ++m) { bf16_t* rowp = base + (size_t)(row0 + ai * HALF + m * 16) * ldc + col0;
#pragma unroll
                for (int bj = 0; bj < 2; ++bj) { const f32x4 v0 = acc[ai][bj][m][0] * sc, v1 = acc[ai][bj][m][1] * sc;
                    u32x4 w; w.x = cvt_pk_bf16(v0[0], v0[1]); w.y = cvt_pk_bf16(v0[2], v0[3]); w.z = cvt_pk_bf16(v1[0], v1[1]); w.w = cvt_pk_bf16(v1[2], v1[3]);
                    *(u32x4*)(rowp + bj * HALF) = w; } }
    }
};
struct EpiMergeA {
    static constexpr bool PERM = true, AFTER_DRAIN = false;
    float* T1; const bf16_t* G;
    __device__ __forceinline__ void operator()(const f32x4 (&acc)[2][2][4][2], const Unit& u, int wr, int wc, int fr, int fq) const {
        const int row0 = u.pm * BM + wr * 64 + fr, col0 = u.pn * BM + wc * 32 + 8 * fq;
#pragma unroll
        for (int ai = 0; ai < 2; ++ai)
#pragma unroll
            for (int m = 0; m < 4; ++m) { const size_t row = (size_t)(row0 + ai * HALF + m * 16);
#pragma unroll
                for (int bj = 0; bj < 2; ++bj) { const int c = col0 + bj * HALF; const u32x4 g = *(const u32x4*)(G + row * 2048 + c);
                    f32x4 v0 = acc[ai][bj][m][0], v1 = acc[ai][bj][m][1];
                    v0[0] *= sigm(bf_lo(g.x)); v0[1] *= sigm(bf_hi(g.x)); v0[2] *= sigm(bf_lo(g.y)); v0[3] *= sigm(bf_hi(g.y));
                    v1[0] *= sigm(bf_lo(g.z)); v1[1] *= sigm(bf_hi(g.z)); v1[2] *= sigm(bf_lo(g.w)); v1[3] *= sigm(bf_hi(g.w));
                    *(f32x4*)(T1 + row * 1024 + c) = v0; *(f32x4*)(T1 + row * 1024 + c + 4) = v1; } }
    }
};
struct EpiMergeB {
    static constexpr bool PERM = true, AFTER_DRAIN = false;
    const float* T1; const bf16_t* G; bf16_t* MG;
    __device__ __forceinline__ void operator()(const f32x4 (&acc)[2][2][4][2], const Unit& u, int wr, int wc, int fr, int fq) const {
        const int row0 = u.pm * BM + wr * 64 + fr, col0 = u.pn * BM + wc * 32 + 8 * fq;
#pragma unroll
        for (int ai = 0; ai < 2; ++ai)
#pragma unroll
            for (int m = 0; m < 4; ++m) { const size_t row = (size_t)(row0 + ai * HALF + m * 16);
#pragma unroll
                for (int bj = 0; bj < 2; ++bj) { const int c = col0 + bj * HALF; const u32x4 g = *(const u32x4*)(G + row * 2048 + c);
                    f32x4 v0 = acc[ai][bj][m][0], v1 = acc[ai][bj][m][1]; const f32x4 t0 = *(const f32x4*)(T1 + row * 1024 + c), t1 = *(const f32x4*)(T1 + row * 1024 + c + 4);
                    v0[0] = t0[0] + v0[0] * sigm(bf_lo(g.x)); v0[1] = t0[1] + v0[1] * sigm(bf_hi(g.x)); v0[2] = t0[2] + v0[2] * sigm(bf_lo(g.y)); v0[3] = t0[3] + v0[3] * sigm(bf_hi(g.y));
                    v1[0] = t1[0] + v1[0] * sigm(bf_lo(g.z)); v1[1] = t1[1] + v1[1] * sigm(bf_hi(g.z)); v1[2] = t1[2] + v1[2] * sigm(bf_lo(g.w)); v1[3] = t1[3] + v1[3] * sigm(bf_hi(g.w));
                    u32x4 w; w.x = cvt_pk_bf16(v0[0], v0[1]); w.y = cvt_pk_bf16(v0[2], v0[3]); w.z = cvt_pk_bf16(v1[0], v1[1]); w.w = cvt_pk_bf16(v1[2], v1[3]);
                    *(u32x4*)(MG + row * 1024 + c) = w; } }
    }
};
struct EpiPreLN {
    static constexpr bool PERM = false, AFTER_DRAIN = false;
    const float* base; float* out; float alpha;
    __device__ __forceinline__ void operator()(const f32x4 (&acc)[2][2][4][2], const Unit& u, int wr, int wc, int fr, int fq) const {
        const int row0 = u.pm * BM + wr * 64 + fr, col0 = u.pn * BM + wc * 32 + 4 * fq;
#pragma unroll
        for (int ai = 0; ai < 2; ++ai)
#pragma unroll
            for (int m = 0; m < 4; ++m) { const size_t off = (size_t)(row0 + ai * HALF + m * 16) * 1024 + col0;
#pragma unroll
                for (int bj = 0; bj < 2; ++bj)
#pragma unroll
                    for (int n = 0; n < 2; ++n) { const f32x4 b = *(const f32x4*)(base + off + bj * HALF + n * 16); *(f32x4*)(out + off + bj * HALF + n * 16) = b * alpha + acc[ai][bj][m][n]; } }
    }
};
struct EpiSwiGLU {
    static constexpr bool PERM = true, AFTER_DRAIN = false;
    bf16_t* FH;
    __device__ __forceinline__ void operator()(const f32x4 (&acc)[2][2][4][2], const Unit& u, int wr, int wc, int fr, int fq) const {
        const int row0 = u.pm * BM + wr * 64 + fr, col0 = u.pn * HALF + wc * 32 + 8 * fq;
#pragma unroll
        for (int ai = 0; ai < 2; ++ai)
#pragma unroll
            for (int m = 0; m < 4; ++m) { bf16_t* rowp = FH + (size_t)(row0 + ai * HALF + m * 16) * 2816 + col0;
                f32x4 v0, v1;
#pragma unroll
                for (int i = 0; i < 4; ++i) { const float g0 = acc[ai][0][m][0][i], g1 = acc[ai][0][m][1][i]; v0[i] = g0 * sigm(g0) * acc[ai][1][m][0][i]; v1[i] = g1 * sigm(g1) * acc[ai][1][m][1][i]; }
                u32x4 w; w.x = cvt_pk_bf16(v0[0], v0[1]); w.y = cvt_pk_bf16(v0[2], v0[3]); w.z = cvt_pk_bf16(v1[0], v1[1]); w.w = cvt_pk_bf16(v1[2], v1[3]);
                *(u32x4*)rowp = w; }
    }
};

template <class Epi, class Sched, bool ALIGN_EPI = false, bool SP2 = false>
__device__ __forceinline__ void gemm_phase(PG8_LAS unsigned char* lds, const Gemm g, const Sched& S, const Epi& E) {
    const int tid = threadIdx.x, wid = __builtin_amdgcn_readfirstlane(tid >> 6), lane = tid & 63, wr = wid >> 2, wc = wid & 3, fr = lane & 15, fq = lane >> 4;
    const int K = g.K, nt = K / BK, lda = g.lda, ldb = g.ldb;
    unsigned voffA[2], voffB[2];
#pragma unroll
    for (int i = 0; i < 2; ++i) { int R, C; stage_rc(tid * 16 + i * 8192, R, C); const int Rb = Epi::PERM ? ((R & ~31) + perm32(R & 31)) : R;
        voffA[i] = (unsigned)(R * lda + C) * 2u; voffB[i] = (unsigned)(Rb * ldb + C) * 2u; }
    const size_t kstep = (size_t)(BK * 2);
    const size_t hstepA = (size_t)HALF * lda * 2, hstepB = (size_t)HALF * ldb * 2;
    const size_t tstepA = 2 * hstepA, tstepB = 2 * hstepB;
    const unsigned ldsw = (unsigned)wid * 1024u;
    const int aoff = lds_byte(wr * 64 + fr, fq * 8), boff = lds_byte(wc * 32 + fr, fq * 8);
#define PG8_SA(b, h) (((b) * 2 + (h)) * HTB)
#define PG8_SB(b, h) ((4 + (b) * 2 + (h)) * HTB)
#define PG8_STAGE(bufoff, gbase, voff) do { _Pragma("unroll") for (int _i = 0; _i < 2; ++_i) \
        __builtin_amdgcn_global_load_lds((const unsigned*)((const char*)(gbase) + (voff)[_i]), (PG8_LAS unsigned*)(lds + (bufoff) + ldsw + _i * 8192), 16, 0, 0); } while (0)
#define PG8_LDA(dst, b, h) do { _Pragma("unroll") for (int m = 0; m < 4; ++m) _Pragma("unroll") for (int k = 0; k < 2; ++k) dst[m][k] = *(const PG8_LAS bf16x8*)(lds + PG8_SA(b, h) + aoff + m * 2048 + k * 1024); } while (0)
#define PG8_LDB(dst, b, h) do { _Pragma("unroll") for (int n = 0; n < 2; ++n) _Pragma("unroll") for (int k = 0; k < 2; ++k) dst[n][k] = *(const PG8_LAS bf16x8*)(lds + PG8_SB(b, h) + boff + n * 2048 + k * 1024); } while (0)
#define PG8_MMA(ai, bj, At, Bt) do { __builtin_amdgcn_s_setprio(1); _Pragma("unroll") for (int m = 0; m < 4; ++m) _Pragma("unroll") for (int n = 0; n < 2; ++n) _Pragma("unroll") for (int k = 0; k < 2; ++k) \
        acc[ai][bj][m][n] = __builtin_amdgcn_mfma_f32_16x16x32_bf16(Bt[n][k], At[m][k], acc[ai][bj][m][n], 0, 0, 0); __builtin_amdgcn_s_setprio(0); } while (0)
#define PG8_WAIT_V(n) asm volatile("s_waitcnt vmcnt(" #n ")" ::: "memory")
#define PG8_WAIT_L(n) asm volatile("s_waitcnt lgkmcnt(" #n ")" ::: "memory")
#define PG8_BAR __builtin_amdgcn_s_barrier()
#define PG8_SCHED __builtin_amdgcn_sched_barrier(0)
    Unit cur, nxt; int ui = 0;
    if (!S.next(0, cur)) return;
    f32x4 acc[2][2][4][2];
#pragma unroll
    for (int a = 0; a < 2; ++a)
#pragma unroll
        for (int b = 0; b < 2; ++b)
#pragma unroll
            for (int m = 0; m < 4; ++m)
#pragma unroll
                for (int n = 0; n < 2; ++n) acc[a][b][m][n] = (f32x4){0.f, 0.f, 0.f, 0.f};
    bf16x8 At[4][2], B0[2][2], B1[2][2];
    const char* cA = (const char*)g.A + (size_t)cur.pm * tstepA; const char* cB = (const char*)g.Bt + (size_t)cur.pn * tstepB;
    S.a_ready(cur);
    if constexpr (SP2) {
        PG8_STAGE(PG8_SB(0, 0), cB, voffB); PG8_STAGE(PG8_SB(0, 1), cB + hstepB, voffB); PG8_STAGE(PG8_SA(0, 0), cA, voffA); PG8_STAGE(PG8_SA(0, 1), cA + hstepA, voffA);
        if (wr == 1) PG8_BAR;
        PG8_WAIT_V(2); PG8_BAR;
        PG8_STAGE(PG8_SB(1, 0), cB + kstep, voffB); PG8_STAGE(PG8_SA(1, 0), cA + kstep, voffA); PG8_STAGE(PG8_SB(1, 1), cB + hstepB + kstep, voffB);
        PG8_WAIT_V(6); PG8_BAR;
    } else {
        PG8_STAGE(PG8_SB(0, 0), cB, voffB); PG8_STAGE(PG8_SA(0, 0), cA, voffA); PG8_STAGE(PG8_SB(0, 1), cB + hstepB, voffB); PG8_STAGE(PG8_SA(0, 1), cA + hstepA, voffA);
        if (wr == 1) PG8_BAR;
        PG8_WAIT_V(4); PG8_BAR;
        PG8_STAGE(PG8_SB(1, 0), cB + kstep, voffB); PG8_STAGE(PG8_SA(1, 0), cA + kstep, voffA); PG8_STAGE(PG8_SB(1, 1), cB + hstepB + kstep, voffB);
        PG8_WAIT_V(6); PG8_BAR;
    }
    for (;;) {
        const bool has_next = S.next(ui + 1, nxt);
        const char* nA = has_next ? (const char*)g.A + (size_t)nxt.pm * tstepA : cA; const char* nB = has_next ? (const char*)g.Bt + (size_t)nxt.pn * tstepB : cB;
        for (int t = 0; t < nt; t += 2) {
            const bool last = (t == nt - 2);
            const char* a1 = cA + (size_t)(t + 1) * kstep;
            const char* a2 = last ? nA : cA + (size_t)(t + 2) * kstep; const char* b2 = last ? nB : cB + (size_t)(t + 2) * kstep;
            const char* a3 = a2 + kstep; const char* b3 = b2 + kstep;
            if (last && has_next) S.a_ready(nxt);
            if constexpr (SP2) {
            PG8_LDB(B0, 0, 0); PG8_LDB(B1, 0, 1); PG8_SCHED; PG8_LDA(At, 0, 0); PG8_STAGE(PG8_SA(1, 1), a1 + hstepA, voffA);
            PG8_WAIT_V(8); PG8_WAIT_L(0); PG8_BAR; PG8_MMA(0, 0, At, B0); PG8_MMA(0, 1, At, B1); PG8_BAR; PG8_SCHED;
            PG8_LDA(At, 0, 1); PG8_STAGE(PG8_SB(0, 0), b2, voffB); PG8_STAGE(PG8_SB(0, 1), b2 + hstepB, voffB); PG8_STAGE(PG8_SA(0, 0), a2, voffA);
            PG8_WAIT_V(8); PG8_WAIT_L(0); PG8_BAR; PG8_MMA(1, 0, At, B0); PG8_MMA(1, 1, At, B1); PG8_BAR; PG8_SCHED;
            PG8_LDB(B0, 1, 0); PG8_LDB(B1, 1, 1); PG8_SCHED; PG8_LDA(At, 1, 0); PG8_STAGE(PG8_SA(0, 1), a2 + hstepA, voffA);
            PG8_WAIT_V(8); PG8_WAIT_L(0); PG8_BAR; PG8_MMA(0, 0, At, B0); PG8_MMA(0, 1, At, B1); PG8_BAR; PG8_SCHED;
            PG8_LDA(At, 1, 1); PG8_STAGE(PG8_SB(1, 0), b3, voffB); PG8_STAGE(PG8_SB(1, 1), b3 + hstepB, voffB); PG8_STAGE(PG8_SA(1, 0), a3, voffA);
            PG8_WAIT_V(8); PG8_WAIT_L(0); PG8_BAR; PG8_MMA(1, 0, At, B0); PG8_MMA(1, 1, At, B1); PG8_BAR; PG8_SCHED;
            } else {
            PG8_LDB(B0, 0, 0); PG8_SCHED; PG8_LDA(At, 0, 0); PG8_STAGE(PG8_SA(1, 1), a1 + hstepA, voffA);
            PG8_WAIT_L(8); PG8_BAR; PG8_WAIT_L(0); PG8_MMA(0, 0, At, B0); PG8_BAR; PG8_SCHED;
            PG8_LDB(B1, 0, 1); PG8_STAGE(PG8_SB(0, 0), b2, voffB);
            PG8_BAR; PG8_WAIT_L(0); PG8_MMA(0, 1, At, B1); PG8_BAR;
            PG8_LDA(At, 0, 1); PG8_STAGE(PG8_SA(0, 0), a2, voffA);
            PG8_BAR; PG8_WAIT_L(0); PG8_MMA(1, 0, At, B0); PG8_BAR; PG8_SCHED;
            PG8_STAGE(PG8_SB(0, 1), b2 + hstepB, voffB);
            PG8_WAIT_V(6); PG8_BAR; PG8_MMA(1, 1, At, B1); PG8_BAR;
            PG8_LDB(B0, 1, 0); PG8_SCHED; PG8_LDA(At, 1, 0); PG8_STAGE(PG8_SA(0, 1), a2 + hstepA, voffA);
            PG8_WAIT_L(8); PG8_BAR; PG8_WAIT_L(0); PG8_MMA(0, 0, At, B0); PG8_BAR; PG8_SCHED;
            PG8_LDB(B1, 1, 1); PG8_STAGE(PG8_SB(1, 0), b3, voffB);
            PG8_BAR; PG8_WAIT_L(0); PG8_MMA(0, 1, At, B1); PG8_BAR;
            PG8_LDA(At, 1, 1); PG8_STAGE(PG8_SA(1, 0), a3, voffA);
            PG8_BAR; PG8_WAIT_L(0); PG8_MMA(1, 0, At, B0); PG8_BAR; PG8_SCHED;
            PG8_STAGE(PG8_SB(1, 1), b3 + hstepB, voffB);
            PG8_WAIT_V(6); PG8_BAR; PG8_MMA(1, 1, At, B1); PG8_BAR;
            }
        }
        if constexpr (ALIGN_EPI) { if (wr == 0) PG8_BAR; }
        if constexpr (!Epi::AFTER_DRAIN) { E(acc, cur, wr, wc, fr, fq); S.done(cur); }
        if (!has_next) break;
#pragma unroll
        for (int a = 0; a < 2; ++a)
#pragma unroll
            for (int b = 0; b < 2; ++b)
#pragma unroll
                for (int m = 0; m < 4; ++m)
#pragma unroll
                    for (int n = 0; n < 2; ++n) acc[a][b][m][n] = (f32x4){0.f, 0.f, 0.f, 0.f};
        cur = nxt; cA = nA; cB = nB; ++ui;
        if constexpr (ALIGN_EPI) { if (wr == 1) PG8_BAR; }
    }
    PG8_WAIT_V(0);
    if constexpr (!ALIGN_EPI) { if (wr == 0) PG8_BAR; }
    PG8_BAR;
    if constexpr (Epi::AFTER_DRAIN) { E.fused(acc, cur, wr, wc, fr, fq, lds, wid, lane); S.done(cur); }
#undef PG8_SA
#undef PG8_SB
#undef PG8_STAGE
#undef PG8_LDA
#undef PG8_LDB
#undef PG8_MMA
#undef PG8_WAIT_V
#undef PG8_WAIT_L
#undef PG8_BAR
#undef PG8_SCHED
}
}

constexpr int NWAVES = 8;
#ifndef MK_N_LAUNCHES
#define MK_N_LAUNCHES 1
#endif
constexpr int NPHASE = 12;
constexpr int BATCH = 8, T = 4096, D = 1024, M = BATCH * T;
constexpr int NPROJ = 6656;
constexpr int DFF = 2816, NGU = 2 * DFF;
constexpr float LN_EPS = 1e-5f, RMS_EPS = 1e-6f, DN_ALPHA = 1.189207115002721f;
constexpr size_t MiB = 1u << 20;
constexpr size_t WS_CTL = 0, CTL_ZERO_BYTES = 1 * MiB;
constexpr size_t WS_WIN = 1 * MiB, WS_WAB = 14 * MiB, WS_WOUT = 18 * MiB, WS_WGU = 20 * MiB, WS_WD = 31 * MiB;
constexpr size_t WS_ROPE = 37 * MiB, WS_DLOW = 39 * MiB, WS_DL = 41 * MiB;
constexpr size_t WS_XB = 42 * MiB;
constexpr size_t WS_QA = 106 * MiB, WS_KA = 138 * MiB, WS_VA = 170 * MiB, WS_RA = 234 * MiB, WS_QB = 298 * MiB, WS_KVB = 362 * MiB;
constexpr size_t WS_OAB = 378 * MiB, WS_END = 506 * MiB;
constexpr size_t WS_T1 = 106 * MiB;
constexpr size_t WS_MG = WS_XB;
constexpr size_t WS_H1B = 106 * MiB;
constexpr size_t WS_FH = 170 * MiB;
static_assert(WS_FH + (size_t)M * DFF * 2 <= WS_KVB && WS_OAB + (size_t)M * 2048 * 2 <= WS_END, "ws map");
constexpr int CW_TMO = 0, CW_CODE = 1, CW_BAR = 4096;
constexpr int RING_OFF = 0, RING_BYTES = 131072;
constexpr int LDSCTL_OFF = RING_BYTES, MISC_OFF = LDSCTL_OFF + 320;
constexpr int LDS_BYTES = 147456;

#define GAS __attribute__((address_space(1)))
#define LAS __attribute__((address_space(3)))
typedef unsigned short bf16;
typedef unsigned v4u __attribute__((ext_vector_type(4)));
typedef unsigned v2u __attribute__((ext_vector_type(2)));
typedef float f32x4 __attribute__((ext_vector_type(4)));
typedef GAS unsigned gu32;
#define RLX_AGENT __ATOMIC_RELAXED, __HIP_MEMORY_SCOPE_AGENT
#define LDS_WAIT() asm volatile("s_waitcnt lgkmcnt(0)" ::: "memory")
#define VM_WAIT() asm volatile("s_waitcnt vmcnt(0)" ::: "memory")
__device__ __forceinline__ unsigned f2bf(float f) { unsigned u = __builtin_bit_cast(unsigned, f); return (u + 0x7fffu + ((u >> 16) & 1u)) >> 16; }
__device__ __forceinline__ unsigned pk2(float lo, float hi) { return f2bf(lo) | (f2bf(hi) << 16); }
__device__ __forceinline__ float bf2f(bf16 v) { return __uint_as_float((unsigned)v << 16); }
using pg8::bf_lo; using pg8::bf_hi; using pg8::sigm;

#define XB_TMO      128
#define XB_XCNT(j)  (256  + 64 * (j))
#define XB_XSUB(j)  (1280 + 64 * (j))
#define XB_XGEN(j)  (2304 + 64 * (j))
#define XB_TOP      3328
#define XB_TOPGEN   3392
#define XCD_BAR_WORDS 3456
#define XB_SPIN_CAP (1u << 18)

__device__ __forceinline__ unsigned xb_ld(unsigned* p)              { return __hip_atomic_load(p, __ATOMIC_RELAXED, __HIP_MEMORY_SCOPE_AGENT); }
__device__ __forceinline__ unsigned xb_add(unsigned* p, unsigned v) { return __hip_atomic_fetch_add(p, v, __ATOMIC_RELAXED, __HIP_MEMORY_SCOPE_AGENT); }
__device__ __forceinline__ unsigned xb_xcc_id() { return (unsigned)__builtin_amdgcn_s_getreg((3 << 11) | 20) & 0xFu; }
#define XB_SPIN(cond, bar) do { unsigned _sp = 0; while (cond) { __builtin_amdgcn_s_sleep(1); \
    if ((++_sp & 255u) == 0u) { if (xb_ld(&(bar)[XB_TMO])) break; if (_sp > XB_SPIN_CAP) { atomicAdd(&(bar)[XB_TMO], 1u); break; } } } } while (0)

struct XcdBarrier {
    unsigned* bar; unsigned x;
    volatile LAS unsigned* st;
};

__device__ __forceinline__ XcdBarrier xcd_barrier_post(unsigned* bar, volatile LAS unsigned* st) {
    XcdBarrier b; b.bar = bar; b.x = xb_xcc_id(); b.st = st;
    if (threadIdx.x == 0) (void)xb_add(&bar[XB_XCNT(b.x)], 1u);
    return b;
}
__device__ __forceinline__ void xcd_barrier_complete(unsigned* bar, unsigned x, unsigned& nloc, unsigned& nx) {
    const unsigned G = gridDim.x * gridDim.y * gridDim.z;
    unsigned sum, cnt, mine, sp = 0u;
    for (;;) {
        sum = 0u; cnt = 0u; mine = 0u;
#pragma unroll
        for (unsigned j = 0; j < 16; ++j) { const unsigned c = xb_ld(&bar[XB_XCNT(j)]); sum += c; cnt += (c > 0u) ? 1u : 0u; mine = (j == x) ? c : mine; }
        if (sum == G) break;
        __builtin_amdgcn_s_sleep(1);
        if ((++sp & 255u) == 0u) { if (xb_ld(&bar[XB_TMO])) break; if (sp > XB_SPIN_CAP) { atomicAdd(&bar[XB_TMO], 1u); break; } }
    }
    nloc = mine > 0u ? mine : 1u; nx = cnt > 0u ? cnt : 1u;
}

__device__ __forceinline__ void xcd_barrier(const XcdBarrier& b) {
    asm volatile("s_waitcnt vmcnt(0)" ::: "memory");
    __syncthreads();
    if (threadIdx.x == 0) {
        unsigned* bar = b.bar;
        __builtin_amdgcn_s_waitcnt(0);
        unsigned nloc = b.st[0], nx = b.st[1];
        if (nloc == 0u) { xcd_barrier_complete(bar, b.x, nloc, nx); b.st[0] = nloc; b.st[1] = nx; }
        const unsigned old = xb_add(&bar[XB_XSUB(b.x)], 1u);
        const unsigned gen = old / nloc;
        if (old + 1u == (gen + 1u) * nloc) {
            __builtin_amdgcn_fence(__ATOMIC_RELEASE, "agent");
            asm volatile("s_waitcnt vmcnt(0)" ::: "memory");
            const unsigned og = xb_add(&bar[XB_TOP], 1u);
            const unsigned tg = og / nx;
            if (og + 1u == (tg + 1u) * nx) xb_add(&bar[XB_TOPGEN], 1u);
            else XB_SPIN(xb_ld(&bar[XB_TOPGEN]) == tg, bar);
            __builtin_amdgcn_fence(__ATOMIC_ACQUIRE, "agent");
            xb_add(&bar[XB_XGEN(b.x)], 1u);
            asm volatile("s_waitcnt vmcnt(0)" ::: "memory");
        } else {
            XB_SPIN(xb_ld(&bar[XB_XGEN(b.x)]) == gen, bar);
            __builtin_amdgcn_fence(__ATOMIC_ACQUIRE, "agent");
            asm volatile("s_waitcnt vmcnt(0)" ::: "memory");
        }
    }
    __syncthreads();
}

struct Frame {
    LAS unsigned char* lds;
    volatile LAS unsigned* MISC;
    gu32* ctl;
    int tid, lane, wave, vcu, G;
    const float* x; const int* pos; const float *w_in, *w_du, *b_dec, *gn_g, *w_a, *w_b, *sinks, *w_out, *ln1g, *ln1b, *w_g, *w_u, *w_d, *ln2g, *ln2b;
    float* out; unsigned char* ws;
};
__device__ __forceinline__ float wave_sum(float v) {
#pragma unroll
    for (int o = 1; o < 64; o <<= 1) v += __shfl_xor(v, o);
    return v;
}
__device__ __forceinline__ float wave_max(float v) {
#pragma unroll
    for (int o = 1; o < 64; o <<= 1) v = fmaxf(v, __shfl_xor(v, o));
    return v;
}
__device__ __forceinline__ void tr_item(const float* W, int ldsrc, int k0, int sn0, int nvalid, bf16* WT, int ldd, int dn0, int dk0, LAS float* scr, int lane) {
#pragma unroll 8
    for (int i = 0; i < 32; ++i) { const int kk = 2 * i + (lane >> 5), n = lane & 31; float v = 0.f; if (sn0 >= 0 && n < nvalid) v = W[(size_t)(k0 + kk) * ldsrc + sn0 + n]; scr[kk * 33 + n] = v; }
    LDS_WAIT(); asm volatile("" ::: "memory");
    const int c = lane & 7;
#pragma unroll
    for (int j = 0; j < 4; ++j) { const int n = (lane >> 3) + 8 * j; const LAS float* s = scr + (8 * c) * 33 + n;
        v4u o; o.x = pk2(s[0 * 33], s[1 * 33]); o.y = pk2(s[2 * 33], s[3 * 33]); o.z = pk2(s[4 * 33], s[5 * 33]); o.w = pk2(s[6 * 33], s[7 * 33]);
        *(GAS v4u*)(WT + (size_t)(dn0 + n) * ldd + dk0 + k0 + 8 * c) = o; }
    LDS_WAIT(); asm volatile("" ::: "memory");
}
__device__ __forceinline__ void p0_prologue(Frame& F) {
    LAS float* scr = (LAS float*)(F.lds + RING_OFF + F.wave * 16384);
    const int gw = F.vcu * NWAVES + F.wave, NGW = F.G * NWAVES;
    bf16* WIN_t = (bf16*)(F.ws + WS_WIN); bf16* WAB_t = (bf16*)(F.ws + WS_WAB); bf16* WOUT_t = (bf16*)(F.ws + WS_WOUT); bf16* WGU_t = (bf16*)(F.ws + WS_WGU); bf16* WD_t = (bf16*)(F.ws + WS_WD);
    constexpr int I_IN = 16 * 208, I_SQ = 16 * 32, I_FF = 16 * 88, I_DN = 44 * 32;
    constexpr int NITEMS = I_IN + 3 * I_SQ + 2 * I_FF + I_DN;
    for (int it = gw; it < NITEMS; it += NGW) {
        int r = it;
        if (r < I_IN) { const int kb = r / 208, nb = r % 208, dn0 = 32 * nb; int sn0, nv = 32;
            if (dn0 < 3072) sn0 = dn0; else if (dn0 < 6400) sn0 = dn0 + 16; else if (dn0 == 6400) { sn0 = 3072; nv = 16; } else sn0 = -1;
            tr_item(F.w_in, 6416, 64 * kb, sn0, nv, WIN_t, 1024, dn0, 0, scr, F.lane); continue; } r -= I_IN;
        if (r < I_SQ) { tr_item(F.w_a, 1024, 64 * (r / 32), 32 * (r % 32), 32, WAB_t, 2048, 32 * (r % 32), 0, scr, F.lane); continue; } r -= I_SQ;
        if (r < I_SQ) { tr_item(F.w_b, 1024, 64 * (r / 32), 32 * (r % 32), 32, WAB_t, 2048, 32 * (r % 32), 1024, scr, F.lane); continue; } r -= I_SQ;
        if (r < I_SQ) { tr_item(F.w_out, 1024, 64 * (r / 32), 32 * (r % 32), 32, WOUT_t, 1024, 32 * (r % 32), 0, scr, F.lane); continue; } r -= I_SQ;
        if (r < I_FF) { const int sn0 = 32 * (r % 88); tr_item(F.w_g, DFF, 64 * (r / 88), sn0, 32, WGU_t, 1024, 256 * (sn0 / 128) + (sn0 % 128), 0, scr, F.lane); continue; } r -= I_FF;
        if (r < I_FF) { const int sn0 = 32 * (r % 88); tr_item(F.w_u, DFF, 64 * (r / 88), sn0, 32, WGU_t, 1024, 256 * (sn0 / 128) + 128 + (sn0 % 128), 0, scr, F.lane); continue; } r -= I_FF;
        tr_item(F.w_d, 1024, 64 * (r / 32), 32 * (r % 32), 32, WD_t, DFF, 32 * (r % 32), 0, scr, F.lane);
    }
    bf16* XB = (bf16*)(F.ws + WS_XB);
    for (int m = gw; m < M; m += NGW) {
        const GAS f32x4* xr = (const GAS f32x4*)(F.x + (size_t)m * D) + F.lane; GAS v2u* o8 = (GAS v2u*)(XB + (size_t)m * D) + F.lane;
#pragma unroll
        for (int j = 0; j < 4; ++j) { const f32x4 v = xr[64 * j]; v2u o; o.x = pk2(v.x, v.y); o.y = pk2(v.z, v.w); o8[64 * j] = o; }
    }
    float* ROPE = (float*)(F.ws + WS_ROPE);
    const int gt = F.vcu * (NWAVES * 64) + F.tid, NGT = F.G * NWAVES * 64;
    for (int i = gt; i < M * 8; i += NGT) { const int m = i >> 3, j = i & 7;
        const float invf[8] = {1.0f, 0.1939227432012558f, 0.03760603070259094f, 0.007292664609849453f, 0.0014142135623842478f, 0.00027424818836152554f, 5.3182957344688475e-05f, 1.0313385246263351e-05f};
        float fr = 1.0f;
#pragma unroll
        for (int q = 0; q < 8; ++q) if (j == q) fr = invf[q];
        const float ang = (float)F.pos[m] * fr; float s, c; sincosf(ang, &s, &c); ROPE[m * 16 + j] = c; ROPE[m * 16 + 8 + j] = s; }
}

typedef float f32x16 __attribute__((ext_vector_type(16)));
typedef short bf16x8 __attribute__((ext_vector_type(8)));
typedef short s16x4 __attribute__((ext_vector_type(4)));
typedef short v4i16_t __attribute__((ext_vector_type(4)));
__device__ __forceinline__ void glds16_asm(const void* gsrc, unsigned lds_dst) { unsigned keep;
    asm volatile("s_mov_b32 %0, m0\n\ts_mov_b32 m0, %2\n\ts_nop 0\n\tglobal_load_lds_dwordx4 %1, off\n\ts_mov_b32 m0, %0" : "=&s"(keep) : "v"(gsrc), "s"(lds_dst) : "memory"); }
template <int CTRL> __device__ __forceinline__ float dpp_f(float v) { return __builtin_bit_cast(float, __builtin_amdgcn_update_dpp(0, __builtin_bit_cast(int, v), CTRL, 0xf, 0xf, true)); }
__device__ __forceinline__ s16x4 tr16(const LAS unsigned char* p) { return __builtin_bit_cast(s16x4, __builtin_amdgcn_ds_read_tr16_b64_v4i16((LAS v4i16_t*)p)); }
__device__ __forceinline__ bf16x8 cat8(s16x4 lo, s16x4 hi) { return (bf16x8){lo[0], lo[1], lo[2], lo[3], hi[0], hi[1], hi[2], hi[3]}; }
__device__ __forceinline__ unsigned cvtpk(float lo, float hi) { typedef float f2 __attribute__((ext_vector_type(2))); typedef __bf16 b2 __attribute__((ext_vector_type(2))); f2 v = {lo, hi}; b2 b = __builtin_convertvector(v, b2); return __builtin_bit_cast(unsigned, b); }
__device__ __forceinline__ int sw256(int row, int ch) { return row * 256 + ((ch ^ (((row & 3) << 2) | ((row >> 2) & 3))) << 4); }
__device__ __forceinline__ int sw128(int row, int ch) { return row * 128 + ((ch ^ (row & 7)) << 4); }
constexpr int GL_GN = 125952;
constexpr int GL_QI = 0, GL_KO = 32768, GL_KI = 65536, GL_P = 81920, GL_DEC = 90112, GL_SSQ = 91136, GL_VST = 93184;
template <bool PASS1> __device__ __forceinline__ void gla_item(Frame& F, int item) {
    const int bh = item >> 3, sc = item & 7, c0 = 8 * sc;
    float* SL = (float*)(F.ws + WS_XB) + (size_t)item * 32768; float* DL = (float*)(F.ws + WS_DL) + item * 128;
    const int b = bh >> 2, hh = bh & 3, tid = F.tid, l = F.lane, w = F.wave;
    const int r32 = l & 31, h2 = l >> 5, tl = l & 15, q4 = l >> 4;
    LAS unsigned char* L = F.lds;
    const bf16* QA = (const bf16*)(F.ws + WS_QA); const bf16* KA = (const bf16*)(F.ws + WS_KA); const bf16* VA = (const bf16*)(F.ws + WS_VA); const bf16* RA = (const bf16*)(F.ws + WS_RA);
    const float* DLOW = (const float*)(F.ws + WS_DLOW); bf16* OAB = (bf16*)(F.ws + WS_OAB);
    s16x4 Ahi, Alo;
#pragma unroll
    for (int j = 0; j < 4; ++j) { const float v = F.w_du[(4 * q4 + j) * 512 + hh * 128 + 16 * w + tl]; const unsigned hi = f2bf(v); const unsigned lo = f2bf(v - __uint_as_float(hi << 16)); Ahi[j] = (short)hi; Alo[j] = (short)lo; }
    const int d0 = 16 * w + 4 * q4;
    const f32x4 bias4 = *(const f32x4*)(F.b_dec + hh * 128 + d0);
    if (!PASS1 && tid < 64) *(LAS f32x4*)(L + GL_GN + tid * 16) = *(const f32x4*)(F.gn_g + 4 * tid);
    f32x16 S[4];
#pragma unroll
    for (int i = 0; i < 4; ++i) { S[i] = (f32x16){};
        if (!PASS1) {
#pragma unroll
            for (int e = 0; e < 16; ++e) S[i][e] = SL[(32 * i + (e & 3) + 8 * (e >> 2) + 4 * h2) * 256 + 32 * w + r32]; } }
    float bsum[4] = {0.f, 0.f, 0.f, 0.f};
    if (!PASS1) *(LAS v4u*)(L + GL_P + tid * 16) = (v4u){0u, 0u, 0u, 0u};
    __syncthreads();
    LAS unsigned char* VST = L + GL_VST + w * 4096; const unsigned vst_lds = (unsigned)(uintptr_t)VST;
    f32x4 pdl[4]; v2u pq[4], pk[4];
#define GLA_ISSUE_V(chn) do { _Pragma("unroll") for (int k_ = 0; k_ < 4; ++k_) glds16_asm(VA + (size_t)(b * T + (chn) * 64 + 16 * k_ + (l >> 2)) * 1024 + hh * 256 + 32 * w + 8 * (l & 3), (unsigned)__builtin_amdgcn_readfirstlane(vst_lds + k_ * 1024)); } while (0)
#define GLA_ISSUE_P(chn) do { const int r0_ = b * T + (chn) * 64; _Pragma("unroll") for (int tile = 0; tile < 4; ++tile) { const int t_ = 16 * tile + tl; \
            pdl[tile] = *(const f32x4*)(DLOW + (size_t)(r0_ + t_) * 16 + 4 * q4); \
            pq[tile] = *(const v2u*)(QA + (size_t)(r0_ + t_) * 512 + hh * 128 + d0); pk[tile] = *(const v2u*)(KA + (size_t)(r0_ + t_) * 512 + hh * 128 + d0); } } while (0)
    GLA_ISSUE_V(c0); GLA_ISSUE_P(c0);
#pragma unroll 1
    for (int ch = c0; ch < c0 + 8; ++ch) {
        const int row0 = b * T + ch * 64, buf = ch & 1, chn = ch + 1; const bool more = ch + 1 < c0 + 8;
        LAS unsigned char* QI = L + GL_QI + buf * 16384; LAS unsigned char* KO = L + GL_KO + buf * 16384; LAS unsigned char* KI = L + GL_KI; LAS float* DEC = (LAS float*)(L + GL_DEC + buf * 512);
        v2u rg[2][4];
        if (!PASS1)
#pragma unroll
        for (int tt = 0; tt < 2; ++tt)
#pragma unroll
            for (int g = 0; g < 4; ++g) rg[tt][g] = *(const v2u*)(RA + (size_t)(row0 + 32 * tt + r32) * 1024 + hh * 256 + 32 * w + 8 * g + 4 * h2);
        float b2[4][4]; float off[4] = {0.f, 0.f, 0.f, 0.f};
#pragma unroll
        for (int tile = 0; tile < 4; ++tile) {
            const int t = 16 * tile + tl;
            s16x4 Bhi, Blo;
            { const f32x4 x0 = pdl[tile];
#pragma unroll
              for (int j = 0; j < 4; ++j) { const float v = x0[j]; const unsigned hi = f2bf(v); const unsigned lo = f2bf(v - __uint_as_float(hi << 16)); Bhi[j] = (short)hi; Blo[j] = (short)lo; } }
            f32x4 z = __builtin_amdgcn_mfma_f32_16x16x16bf16_1k(Ahi, Bhi, (f32x4){0.f, 0.f, 0.f, 0.f}, 0, 0, 0);
            z = __builtin_amdgcn_mfma_f32_16x16x16bf16_1k(Alo, Bhi, z, 0, 0, 0);
            z = __builtin_amdgcn_mfma_f32_16x16x16bf16_1k(Ahi, Blo, z, 0, 0, 0);
#pragma unroll
            for (int e = 0; e < 4; ++e) {
                const float zz = z[e] + bias4[e];
                float la = -0.0625f * __builtin_amdgcn_logf(1.0f + __builtin_amdgcn_exp2f(-1.4426950408889634f * zz));
                la += dpp_f<0x111>(la); la += dpp_f<0x112>(la); la += dpp_f<0x114>(la); la += dpp_f<0x118>(la);
                const float tot = __shfl(la, (l & 48) | 15);
                b2[tile][e] = la + off[e]; off[e] += tot;
            }
        }
        float dl[4];
#pragma unroll
        for (int e = 0; e < 4; ++e) { dl[e] = __builtin_amdgcn_exp2f(off[e]); bsum[e] += off[e]; }
        if (tl == 0) *(LAS f32x4*)(DEC + d0) = (f32x4){dl[0], dl[1], dl[2], dl[3]};
#pragma unroll
        for (int tile = 0; tile < 4; ++tile) {
            const int t = 16 * tile + tl;
            const v2u qw = pq[tile], kw = pk[tile];
            const float qf[4] = {bf_lo(qw.x), bf_hi(qw.x), bf_lo(qw.y), bf_hi(qw.y)}, kf[4] = {bf_lo(kw.x), bf_hi(kw.x), bf_lo(kw.y), bf_hi(kw.y)};
            float qi[4], ki[4], ko[4];
#pragma unroll
            for (int e = 0; e < 4; ++e) { const float E = __builtin_amdgcn_exp2f(b2[tile][e]), Ei = __builtin_amdgcn_exp2f(-b2[tile][e]); qi[e] = qf[e] * E; ki[e] = kf[e] * Ei; ko[e] = ki[e] * dl[e]; }
            const int wo = sw256(t, 2 * w + (q4 >> 1)) + 8 * (q4 & 1);
            if (!PASS1) { *(LAS v2u*)(QI + wo) = (v2u){cvtpk(qi[0], qi[1]), cvtpk(qi[2], qi[3])};
                *(LAS v2u*)(KI + wo) = (v2u){cvtpk(ki[0], ki[1]), cvtpk(ki[2], ki[3])}; }
            *(LAS v2u*)(KO + wo) = (v2u){cvtpk(ko[0], ko[1]), cvtpk(ko[2], ko[3])};
        }
        asm volatile("s_waitcnt lgkmcnt(0)" ::: "memory"); __builtin_amdgcn_s_barrier(); asm volatile("" ::: "memory");
        if (!PASS1) {
#pragma unroll
        for (int rep = 0; rep < 2; ++rep) {
            const int idx = w + 8 * rep;
            if (idx < 10) {
                int ti = 0, si = idx; if (idx >= 6) { ti = 3; si = idx - 6; } else if (idx >= 3) { ti = 2; si = idx - 3; } else if (idx >= 1) { ti = 1; si = idx - 1; }
                f32x4 acc = (f32x4){0.f, 0.f, 0.f, 0.f};
#pragma unroll
                for (int kk = 0; kk < 4; ++kk) { const bf16x8 a = *(const LAS bf16x8*)(QI + sw256(16 * ti + tl, 4 * kk + q4)), bb = *(const LAS bf16x8*)(KI + sw256(16 * si + tl, 4 * kk + q4));
                    acc = __builtin_amdgcn_mfma_f32_16x16x32_bf16(a, bb, acc, 0, 0, 0); }
#pragma unroll
                for (int e = 0; e < 4; ++e) { const int t = 16 * ti + 4 * q4 + e, s = 16 * si + tl; const float v = (t >= s) ? acc[e] : 0.f; *(LAS bf16*)(L + GL_P + sw128(t, s >> 3) + (s & 7) * 2) = (bf16)f2bf(v); }
            }
        }
        asm volatile("s_waitcnt lgkmcnt(0)" ::: "memory"); __builtin_amdgcn_s_barrier(); asm volatile("" ::: "memory");
        }
        asm volatile("s_waitcnt vmcnt(0)" ::: "memory");
        bf16x8 vf[4];
        { const LAS unsigned char* vb = VST + (8 * h2 + (tl >> 2)) * 64 + (16 * (q4 & 1) + 4 * (tl & 3)) * 2;
#pragma unroll
          for (int ks = 0; ks < 4; ++ks) vf[ks] = cat8(tr16(vb + ks * 1024), tr16(vb + ks * 1024 + 256)); }
        asm volatile("s_waitcnt lgkmcnt(0)" ::: "memory");
        if (more) { GLA_ISSUE_V(chn); GLA_ISSUE_P(chn); }
        f32x16 o[2]; o[0] = (f32x16){}; o[1] = (f32x16){};
        if (!PASS1)
#pragma unroll
        for (int tt = 0; tt < 2; ++tt)
#pragma unroll
            for (int ks = 0; ks < 4; ++ks) { const bf16x8 bp = *(const LAS bf16x8*)(L + GL_P + sw128(32 * tt + r32, 2 * ks + h2)); o[tt] = __builtin_amdgcn_mfma_f32_32x32x16_bf16(vf[ks], bp, o[tt], 0, 0, 0); }
#pragma unroll
        for (int i = 0; i < 4; ++i) {
            if (!PASS1)
#pragma unroll
            for (int s = 0; s < 2; ++s) {
                v4u pk; pk.x = cvtpk(S[i][8 * s + 0], S[i][8 * s + 1]); pk.y = cvtpk(S[i][8 * s + 2], S[i][8 * s + 3]); pk.z = cvtpk(S[i][8 * s + 4], S[i][8 * s + 5]); pk.w = cvtpk(S[i][8 * s + 6], S[i][8 * s + 7]);
                const bf16x8 ap = __builtin_bit_cast(bf16x8, pk);
#pragma unroll
                for (int tt = 0; tt < 2; ++tt) { const v2u x0 = *(const LAS v2u*)(QI + sw256(32 * tt + r32, 4 * i + 2 * s) + 8 * h2), x1 = *(const LAS v2u*)(QI + sw256(32 * tt + r32, 4 * i + 2 * s + 1) + 8 * h2);
                    const bf16x8 bq = __builtin_bit_cast(bf16x8, (v4u){x0.x, x0.y, x1.x, x1.y}); o[tt] = __builtin_amdgcn_mfma_f32_32x32x16_bf16(ap, bq, o[tt], 0, 0, 0); }
            }
#pragma unroll
            for (int g = 0; g < 4; ++g) { const f32x4 d4 = *(const LAS f32x4*)(DEC + 32 * i + 8 * g + 4 * h2);
#pragma unroll
                for (int e = 0; e < 4; ++e) S[i][4 * g + e] *= d4[e]; }
            { const int kch = 4 * i + 2 * (q4 & 1) + ((tl & 3) >> 1), kw8 = 8 * (tl & 1); const LAS unsigned char* kb0 = KO + sw256(8 * h2 + (tl >> 2), kch) + kw8; const LAS unsigned char* kb1 = KO + sw256(8 * h2 + 4 + (tl >> 2), kch) + kw8;
#pragma unroll
              for (int ks = 0; ks < 4; ++ks) { const bf16x8 ak = cat8(tr16(kb0 + ks * 4096), tr16(kb1 + ks * 4096)); S[i] = __builtin_amdgcn_mfma_f32_32x32x16_bf16(ak, vf[ks], S[i], 0, 0, 0); } }
        }
        if (!PASS1) {
#pragma unroll
        for (int tt = 0; tt < 2; ++tt) { float ss = 0.f;
#pragma unroll
            for (int e = 0; e < 16; ++e) ss += o[tt][e] * o[tt][e];
            ss += __shfl_xor(ss, 32);
            if (h2 == 0) *(LAS float*)(L + GL_SSQ + (w * 64 + 32 * tt + r32) * 4) = ss; }
        asm volatile("s_waitcnt lgkmcnt(0)" ::: "memory"); __builtin_amdgcn_s_barrier(); asm volatile("" ::: "memory");
#pragma unroll
        for (int tt = 0; tt < 2; ++tt) { float tot = 0.f;
#pragma unroll
            for (int ww = 0; ww < 8; ++ww) tot += *(const LAS float*)(L + GL_SSQ + (ww * 64 + 32 * tt + r32) * 4);
            const float rstd = 1.0f / sqrtf(tot * (1.0f / 256.0f) + RMS_EPS);
#pragma unroll
            for (int g = 0; g < 4; ++g) { const f32x4 gq = *(const LAS f32x4*)(L + GL_GN + (32 * w + 8 * g + 4 * h2) * 4); const float r0 = bf_lo(rg[tt][g].x), r1 = bf_hi(rg[tt][g].x), r2 = bf_lo(rg[tt][g].y), r3 = bf_hi(rg[tt][g].y);
                v2u wv; wv.x = cvtpk(o[tt][4 * g + 0] * rstd * gq[0] * (r0 * sigm(r0)), o[tt][4 * g + 1] * rstd * gq[1] * (r1 * sigm(r1)));
                wv.y = cvtpk(o[tt][4 * g + 2] * rstd * gq[2] * (r2 * sigm(r2)), o[tt][4 * g + 3] * rstd * gq[3] * (r3 * sigm(r3)));
                *(v2u*)(OAB + (size_t)(row0 + 32 * tt + r32) * 2048 + hh * 256 + 32 * w + 8 * g + 4 * h2) = wv; } }
        }
    }
    if (PASS1) {
#pragma unroll
        for (int i = 0; i < 4; ++i)
#pragma unroll
            for (int e = 0; e < 16; ++e) SL[(32 * i + (e & 3) + 8 * (e >> 2) + 4 * h2) * 256 + 32 * w + r32] = S[i][e];
        if (tl == 0) *(f32x4*)(DL + d0) = (f32x4){bsum[0], bsum[1], bsum[2], bsum[3]};
    }
    asm volatile("s_waitcnt vmcnt(0)" ::: "memory");
    __syncthreads();
#undef GLA_ISSUE_V
#undef GLA_ISSUE_P
}

__device__ __forceinline__ void gla_scan(Frame& F) {
    float* SL = (float*)(F.ws + WS_XB); const float* DL = (const float*)(F.ws + WS_DL);
    const int gt = F.vcu * (NWAVES * 64) + F.tid, NGT = F.G * NWAVES * 64;
    for (int e = gt; e < 32 * 8192; e += NGT) { const int bh = e >> 13, rem = e & 8191, dk = rem >> 6;
        f32x4 tmp[8]; float dd[8];
#pragma unroll
        for (int sc = 0; sc < 8; ++sc) { tmp[sc] = *(const f32x4*)(SL + (size_t)(bh * 8 + sc) * 32768 + 4 * rem); dd[sc] = DL[(bh * 8 + sc) * 128 + dk]; }
        f32x4 R = (f32x4){0.f, 0.f, 0.f, 0.f};
#pragma unroll
        for (int sc = 0; sc < 8; ++sc) { *(f32x4*)(SL + (size_t)(bh * 8 + sc) * 32768 + 4 * rem) = R; R = R * __builtin_amdgcn_exp2f(dd[sc]) + tmp[sc]; } }
}
constexpr int SW_K = 0, SW_V = 32768;
__device__ __forceinline__ void swa_unit(Frame& F, int unit) {
    const int qb = unit & 31, g = (unit >> 5) & 1, b = unit >> 6, tid = F.tid, l = F.lane, w = F.wave;
    const int r32 = l & 31, h2 = l >> 5, tl = l & 15, q4 = l >> 4;
    LAS unsigned char* L = F.lds;
    const bf16* QB = (const bf16*)(F.ws + WS_QB); const bf16* KVB = (const bf16*)(F.ws + WS_KVB); const float* ROPE = (const float*)(F.ws + WS_ROPE); bf16* OAB = (bf16*)(F.ws + WS_OAB);
    {
        const int j = tid >> 1, hf = tid & 1, tk = qb * 128 - 128 + j;
        v4u kc[4], vc[4];
        if (tk >= 0) { const size_t row = (size_t)b * T + tk; const v4u* kp = (const v4u*)(KVB + row * 256 + g * 64 + hf * 32); const v4u* vp = (const v4u*)(KVB + row * 256 + 128 + g * 64 + hf * 32);
#pragma unroll
            for (int c = 0; c < 4; ++c) { kc[c] = kp[c]; vc[c] = vp[c]; }
            if (hf == 0) { const f32x4* rp = (const f32x4*)(ROPE + row * 16); const f32x4 c0 = rp[0], c1 = rp[1], s0 = rp[2], s1 = rp[3];
                float x1[8] = {bf_lo(kc[0].x), bf_hi(kc[0].x), bf_lo(kc[0].y), bf_hi(kc[0].y), bf_lo(kc[0].z), bf_hi(kc[0].z), bf_lo(kc[0].w), bf_hi(kc[0].w)};
                float x2[8] = {bf_lo(kc[1].x), bf_hi(kc[1].x), bf_lo(kc[1].y), bf_hi(kc[1].y), bf_lo(kc[1].z), bf_hi(kc[1].z), bf_lo(kc[1].w), bf_hi(kc[1].w)};
                float y1[8], y2[8];
#pragma unroll
                for (int q = 0; q < 8; ++q) { const float c = q < 4 ? c0[q & 3] : c1[q & 3], s = q < 4 ? s0[q & 3] : s1[q & 3]; y1[q] = x1[q] * c - x2[q] * s; y2[q] = x1[q] * s + x2[q] * c; }
                kc[0] = (v4u){cvtpk(y1[0], y1[1]), cvtpk(y1[2], y1[3]), cvtpk(y1[4], y1[5]), cvtpk(y1[6], y1[7])};
                kc[1] = (v4u){cvtpk(y2[0], y2[1]), cvtpk(y2[2], y2[3]), cvtpk(y2[4], y2[5]), cvtpk(y2[6], y2[7])}; }
        } else {
#pragma unroll
            for (int c = 0; c < 4; ++c) { kc[c] = (v4u){0u, 0u, 0u, 0u}; vc[c] = (v4u){0u, 0u, 0u, 0u}; }
        }
#pragma unroll
        for (int c = 0; c < 4; ++c) { const int cg = 4 * hf + c; *(LAS v4u*)(L + SW_K + j * 128 + ((cg ^ (j & 7)) * 16)) = kc[c]; *(LAS v4u*)(L + SW_V + j * 128 + cg * 16) = vc[c]; }
    }
    __syncthreads();
    const int hq = 8 * g + w;
    const float CS = 0.125f * 1.4426950408889634f, sink2 = F.sinks[hq] * 1.4426950408889634f;
    for (int qt = 0; qt < 4; ++qt) {
        const size_t row = (size_t)b * T + qb * 128 + 32 * qt + r32;
        bf16x8 qf[4];
        { const v4u* qp = (const v4u*)(QB + row * 1024 + hq * 64 + 8 * h2);
          v4u q0 = qp[0]; const v4u q1 = qp[2], q2 = qp[4], q3 = qp[6];
          const f32x4* rp = (const f32x4*)(ROPE + row * 16); const f32x4 c0 = rp[0], c1 = rp[1], s0 = rp[2], s1 = rp[3];
          float own[8] = {bf_lo(q0.x), bf_hi(q0.x), bf_lo(q0.y), bf_hi(q0.y), bf_lo(q0.z), bf_hi(q0.z), bf_lo(q0.w), bf_hi(q0.w)}; float y[8];
#pragma unroll
          for (int q = 0; q < 8; ++q) { const float oth = __shfl_xor(own[q], 32); const float c = q < 4 ? c0[q & 3] : c1[q & 3], s = q < 4 ? s0[q & 3] : s1[q & 3];
              y[q] = (h2 == 0) ? (own[q] * c - oth * s) : (oth * s + own[q] * c); }
          q0 = (v4u){cvtpk(y[0], y[1]), cvtpk(y[2], y[3]), cvtpk(y[4], y[5]), cvtpk(y[6], y[7])};
          qf[0] = __builtin_bit_cast(bf16x8, q0); qf[1] = __builtin_bit_cast(bf16x8, q1); qf[2] = __builtin_bit_cast(bf16x8, q2); qf[3] = __builtin_bit_cast(bf16x8, q3); }
        f32x16 st[5];
#pragma unroll
        for (int kr = 0; kr < 5; ++kr) { const int key = 32 * (qt + kr) + r32; const LAS unsigned char* kp = L + SW_K + key * 128; f32x16 acc = (f32x16){};
#pragma unroll
            for (int ks = 0; ks < 4; ++ks) { const bf16x8 a = *(const LAS bf16x8*)(kp + (((2 * ks + h2) ^ (key & 7)) * 16)); acc = __builtin_amdgcn_mfma_f32_32x32x16_bf16(a, qf[ks], acc, 0, 0, 0); }
            st[kr] = acc; }
        float mx = -INFINITY;
#pragma unroll
        for (int kr = 0; kr < 5; ++kr) { const bool tile_ok = (qb > 0) || (qt + kr >= 4);
#pragma unroll
            for (int e = 0; e < 16; ++e) { const int kl = (e & 3) + 8 * (e >> 2) + 4 * h2; bool ok = tile_ok; if (kr == 0) ok = ok && (kl > r32); if (kr == 4) ok = ok && (kl <= r32);
                const float v = ok ? st[kr][e] : -INFINITY; st[kr][e] = v; mx = fmaxf(mx, v); } }
        mx = fmaxf(mx, __shfl_xor(mx, 32));
        const float mc = fmaxf(mx * CS, sink2);
        float lsum = 0.f;
#pragma unroll
        for (int kr = 0; kr < 5; ++kr)
#pragma unroll
            for (int e = 0; e < 16; ++e) { const float p = __builtin_amdgcn_exp2f(st[kr][e] * CS - mc); st[kr][e] = p; lsum += p; }
        lsum += __shfl_xor(lsum, 32);
        const float rden = 1.0f / (lsum + __builtin_amdgcn_exp2f(sink2 - mc));
        f32x16 o[2]; o[0] = (f32x16){}; o[1] = (f32x16){};
#pragma unroll
        for (int kr = 0; kr < 5; ++kr)
#pragma unroll
            for (int s = 0; s < 2; ++s) {
                v4u pk; pk.x = cvtpk(st[kr][8 * s + 0], st[kr][8 * s + 1]); pk.y = cvtpk(st[kr][8 * s + 2], st[kr][8 * s + 3]); pk.z = cvtpk(st[kr][8 * s + 4], st[kr][8 * s + 5]); pk.w = cvtpk(st[kr][8 * s + 6], st[kr][8 * s + 7]);
                const bf16x8 bp = __builtin_bit_cast(bf16x8, pk);
#pragma unroll
                for (int dt = 0; dt < 2; ++dt) { const LAS unsigned char* vb = L + SW_V + (32 * (qt + kr) + 16 * s + 4 * h2 + (tl >> 2)) * 128 + (32 * dt + 16 * (q4 & 1) + 4 * (tl & 3)) * 2;
                    const bf16x8 av = cat8(tr16(vb), tr16(vb + 8 * 128)); o[dt] = __builtin_amdgcn_mfma_f32_32x32x16_bf16(av, bp, o[dt], 0, 0, 0); }
            }
#pragma unroll
        for (int dt = 0; dt < 2; ++dt)
#pragma unroll
            for (int gq = 0; gq < 4; ++gq) { v2u wv; wv.x = cvtpk(o[dt][4 * gq + 0] * rden, o[dt][4 * gq + 1] * rden); wv.y = cvtpk(o[dt][4 * gq + 2] * rden, o[dt][4 * gq + 3] * rden);
                *(v2u*)(OAB + row * 2048 + 1024 + hq * 64 + 32 * dt + 8 * gq + 4 * h2) = wv; }
    }
    __syncthreads();
}
__device__ __forceinline__ void ln_row(Frame& F, const float* in, float* outf, bf16* outb, const float* gam, const float* bet) {
    const GAS f32x4* xr = (const GAS f32x4*)in + F.lane;
    f32x4 v[4]; float s = 0.f;
#pragma unroll
    for (int j = 0; j < 4; ++j) { v[j] = xr[64 * j]; s += (v[j].x + v[j].y) + (v[j].z + v[j].w); }
    const float mean = wave_sum(s) * (1.f / D); float s2 = 0.f;
#pragma unroll
    for (int j = 0; j < 4; ++j) { v[j] = v[j] - mean; s2 += (v[j].x * v[j].x + v[j].y * v[j].y) + (v[j].z * v[j].z + v[j].w * v[j].w); }
    const float rstd = 1.f / sqrtf(wave_sum(s2) * (1.f / D) + LN_EPS);
#pragma unroll
    for (int j = 0; j < 4; ++j) { const f32x4 gg = *((const GAS f32x4*)gam + F.lane + 64 * j), bb = *((const GAS f32x4*)bet + F.lane + 64 * j); const f32x4 y = v[j] * rstd * gg + bb;
        *((GAS f32x4*)outf + F.lane + 64 * j) = y;
        if (outb) { v2u o; o.x = pk2(y.x, y.y); o.y = pk2(y.z, y.w); *((GAS v2u*)outb + F.lane + 64 * j) = o; } }
}

struct Args { const void* in[17]; float* out; unsigned char* ws; int ph_lo, ph_hi; };
__global__ void __launch_bounds__(NWAVES * 64, 2) mk_fwd(Args args) {
    extern __shared__ __attribute__((aligned(16))) unsigned char lds[];
    Frame F;
    F.lds = (LAS unsigned char*)lds;
    F.MISC = (volatile LAS unsigned*)(F.lds + MISC_OFF);
    F.tid = threadIdx.x; F.lane = F.tid & 63; F.wave = __builtin_amdgcn_readfirstlane(F.tid >> 6);
    F.G = gridDim.x; { const int bx = blockIdx.x; F.vcu = (F.G % 8 == 0) ? (bx % 8) * (F.G / 8) + bx / 8 : bx; }
    unsigned char* ws = args.ws; F.ws = ws; F.out = args.out;
    F.ctl = (gu32*)(ws + WS_CTL);
    F.x = (const float*)args.in[0]; F.pos = (const int*)args.in[1]; F.w_in = (const float*)args.in[2]; F.w_du = (const float*)args.in[3]; F.b_dec = (const float*)args.in[4]; F.gn_g = (const float*)args.in[5];
    F.w_a = (const float*)args.in[6]; F.w_b = (const float*)args.in[7]; F.sinks = (const float*)args.in[8]; F.w_out = (const float*)args.in[9]; F.ln1g = (const float*)args.in[10]; F.ln1b = (const float*)args.in[11];
    F.w_g = (const float*)args.in[12]; F.w_u = (const float*)args.in[13]; F.w_d = (const float*)args.in[14]; F.ln2g = (const float*)args.in[15]; F.ln2b = (const float*)args.in[16];
    for (int u = F.tid; u < (LDS_BYTES - LDSCTL_OFF) / 4; u += NWAVES * 64) ((LAS unsigned*)(F.lds + LDSCTL_OFF))[u] = 0u;
    __syncthreads();
    XcdBarrier bar; bar.bar = (unsigned*)(F.ctl + CW_BAR); bar.x = 0; bar.st = nullptr;
    if (MK_N_LAUNCHES == 1) bar = xcd_barrier_post((unsigned*)(F.ctl + CW_BAR), F.MISC + 8);
#define GRID_BAR() do { if (MK_N_LAUNCHES == 1) xcd_barrier(bar); } while (0)
    const int lo = args.ph_lo, hi = args.ph_hi;
#define IN(k) (lo <= (k) && (k) < hi)
#define BOTH(k) (IN(k) && IN((k) + 1))
    pg8::bf16_t* WIN_t = (pg8::bf16_t*)(ws + WS_WIN); pg8::bf16_t* WAB_t = (pg8::bf16_t*)(ws + WS_WAB); pg8::bf16_t* WOUT_t = (pg8::bf16_t*)(ws + WS_WOUT); pg8::bf16_t* WGU_t = (pg8::bf16_t*)(ws + WS_WGU); pg8::bf16_t* WD_t = (pg8::bf16_t*)(ws + WS_WD);
    pg8::bf16_t* XB = (pg8::bf16_t*)(ws + WS_XB); pg8::bf16_t* OAB = (pg8::bf16_t*)(ws + WS_OAB); pg8::bf16_t* MG = (pg8::bf16_t*)(ws + WS_MG); pg8::bf16_t* H1B = (pg8::bf16_t*)(ws + WS_H1B); pg8::bf16_t* FH = (pg8::bf16_t*)(ws + WS_FH);
    pg8::bf16_t* GAB = (pg8::bf16_t*)args.out;
    float* T1 = (float*)(ws + WS_T1);

    if (IN(0)) { p0_prologue(F); if (BOTH(0)) GRID_BAR(); }
    if (IN(1)) {
        pg8::Gemm g{XB, WIN_t, M, NPROJ, D, D, D}; pg8::StaticOrder S; S.init(M, NPROJ, F.G, (int)blockIdx.x);
        pg8::EpiProj E{(pg8::bf16_t*)(ws + WS_QA), (pg8::bf16_t*)(ws + WS_KA), (pg8::bf16_t*)(ws + WS_VA), (pg8::bf16_t*)(ws + WS_RA), (pg8::bf16_t*)(ws + WS_QB), (pg8::bf16_t*)(ws + WS_KVB), GAB, (float*)(ws + WS_DLOW)};
        pg8::gemm_phase<pg8::EpiProj, pg8::StaticOrder, true, true>(F.lds + RING_OFF, g, S, E);
        if (BOTH(1)) GRID_BAR();
    }
    if (IN(2)) {
        gla_item<true>(F, F.vcu);
        for (int u = F.vcu; u < 512; u += F.G) swa_unit(F, u);
        if (BOTH(2)) GRID_BAR();
    }
    if (IN(3)) {
        gla_scan(F);
        if (BOTH(3)) GRID_BAR();
    }
    if (IN(4)) {
        gla_item<false>(F, F.vcu);
        if (BOTH(4)) GRID_BAR();
    }
    if (IN(5)) {
        pg8::Gemm g{OAB, WAB_t, M, D, D, 2048, 2048}; pg8::StaticOrder S; S.init(M, D, F.G, (int)blockIdx.x);
        pg8::EpiMergeA E{T1, GAB};
        pg8::gemm_phase<pg8::EpiMergeA, pg8::StaticOrder, true, true>(F.lds + RING_OFF, g, S, E);
        if (BOTH(5)) GRID_BAR();
    }
    if (IN(6)) {
        pg8::Gemm g{OAB + 1024, WAB_t + 1024, M, D, D, 2048, 2048}; pg8::StaticOrder S; S.init(M, D, F.G, (int)blockIdx.x);
        pg8::EpiMergeB E{T1, GAB + 1024, MG};
        pg8::gemm_phase<pg8::EpiMergeB, pg8::StaticOrder, true, true>(F.lds + RING_OFF, g, S, E);
        if (BOTH(6)) GRID_BAR();
    }
    if (IN(7)) {
        pg8::Gemm g{MG, WOUT_t, M, D, D, D, D}; pg8::StaticOrder S; S.init(M, D, F.G, (int)blockIdx.x);
        pg8::EpiPreLN E{F.x, F.out, DN_ALPHA};
        pg8::gemm_phase<pg8::EpiPreLN, pg8::StaticOrder, true, true>(F.lds + RING_OFF, g, S, E);
        if (BOTH(7)) GRID_BAR();
    }
    if (IN(8)) {
        const int gw = F.vcu * NWAVES + F.wave, NGW = F.G * NWAVES;
        for (int m = gw; m < M; m += NGW) ln_row(F, F.out + (size_t)m * D, F.out + (size_t)m * D, (bf16*)H1B + (size_t)m * D, F.ln1g, F.ln1b);
        if (BOTH(8)) GRID_BAR();
    }
    if (IN(9)) {
        pg8::Gemm g{H1B, WGU_t, M, NGU, D, D, D}; pg8::StaticOrder S; S.init(M, NGU, F.G, (int)blockIdx.x);
        pg8::EpiSwiGLU E{FH};
        pg8::gemm_phase<pg8::EpiSwiGLU, pg8::StaticOrder, true, true>(F.lds + RING_OFF, g, S, E);
        if (BOTH(9)) GRID_BAR();
    }
    if (IN(10)) {
        pg8::Gemm g{FH, WD_t, M, D, DFF, DFF, DFF}; pg8::StaticOrder S; S.init(M, D, F.G, (int)blockIdx.x);
        pg8::EpiPreLN E{F.out, F.out, DN_ALPHA};
        pg8::gemm_phase<pg8::EpiPreLN, pg8::StaticOrder, true, true>(F.lds + RING_OFF, g, S, E);
        if (BOTH(10)) GRID_BAR();
    }
    if (IN(11)) {
        const int gw = F.vcu * NWAVES + F.wave, NGW = F.G * NWAVES;
        for (int m = gw; m < M; m += NGW) ln_row(F, F.out + (size_t)m * D, F.out + (size_t)m * D, nullptr, F.ln2g, F.ln2b);
    }
#undef IN
#undef BOTH
}

extern "C" void kernel_launch(void* const* d_in, const int* in_sizes, int n_in, void* d_out, int out_size, void* d_ws, size_t ws_size, hipStream_t stream) {
    static int grid = 0;
    if (grid == 0) {
        if (n_in != 17 || in_sizes[0] != M * D || out_size != M * D || ws_size < WS_END) { fprintf(stderr, "kernel_launch: unexpected shapes (n_in %d, in0 %d, out %d, ws %zu)\n", n_in, n_in > 0 ? in_sizes[0] : -1, out_size, ws_size); grid = -1; return; }
        int dev = 0, cus = 0, per_cu = 0;
        if (hipGetDevice(&dev) != hipSuccess || hipDeviceGetAttribute(&cus, hipDeviceAttributeMultiprocessorCount, dev) != hipSuccess) { grid = -1; return; }
        if (hipFuncSetAttribute((const void*)mk_fwd, hipFuncAttributeMaxDynamicSharedMemorySize, LDS_BYTES) != hipSuccess) { fprintf(stderr, "kernel_launch: hipFuncSetAttribute failed\n"); grid = -1; return; }
        if (hipOccupancyMaxActiveBlocksPerMultiprocessor(&per_cu, (const void*)mk_fwd, NWAVES * 64, LDS_BYTES) != hipSuccess || per_cu < 1) fprintf(stderr, "kernel_launch: occupancy query reports %d\n", per_cu);
        (void)hipGetLastError();
        grid = cus;
        if (grid != 256) fprintf(stderr, "kernel_launch: %d CUs (built for 256)\n", grid);
    }
    if (grid < 0) return;
    if (hipMemsetAsync((char*)d_ws + WS_CTL, 0, CTL_ZERO_BYTES, stream) != hipSuccess) return;
    Args a{};
    for (int i = 0; i < 17; ++i) a.in[i] = d_in[i];
    a.out = (float*)d_out; a.ws = (unsigned char*)d_ws;
    if (MK_N_LAUNCHES == 1) { a.ph_lo = 0; a.ph_hi = NPHASE; hipLaunchKernelGGL(mk_fwd, dim3(grid), dim3(NWAVES * 64), LDS_BYTES, stream, a); }
    else for (int p = 0; p < NPHASE; ++p) { a.ph_lo = p; a.ph_hi = p + 1; hipLaunchKernelGGL(mk_fwd, dim3(grid), dim3(NWAVES * 64), LDS_BYTES, stream, a); }
}
```
